# Optimizing an MI355X kernel written in HIP

```python
import jax, jax.numpy as jnp
from jax import lax
import numpy as np

D_MODEL = 1024
BATCH = 2
SEQ = 8192
DEPTH = 2

GRID_W = 64
CTX_LEN = 256
NA_HEADS = 8
NA_HEAD_DIM = 64
NA_ROWS = 8
NA_COLS = 16
NA_QCB = 32
NA_KCB = NA_QCB + NA_COLS
HG_HEADS = 4
HG_DK = 128
HG_DV = 128
HG_CHUNK = 64
LOG_FLOOR = 1e-30
WA_HEADS = 8
WA_KV_HEADS = 2
WA_HEAD_DIM = 64
WA_WINDOW = 128
WA_BLOCK = 128
ROPE_THETA = 10000.0
N_EXPERTS = 16
N_GROUPS = 4
EXPERTS_PER_GROUP = N_EXPERTS // N_GROUPS
TOP_K = 2
EXPERT_FF = 512
MOE_BLOCK = 128
N_BRANCHES = 3
NA_W = NA_HEADS * NA_HEAD_DIM
HG_KW = HG_HEADS * HG_DK
HG_VW = HG_HEADS * HG_DV
WA_QW = WA_HEADS * WA_HEAD_DIM
WA_KVW = WA_KV_HEADS * WA_HEAD_DIM
IN_SPLITS = (NA_W, NA_W, NA_W, HG_KW, HG_KW, HG_KW, HG_VW, HG_VW, WA_QW, WA_KVW, WA_KVW, N_BRANCHES * D_MODEL)
IN_COLS = sum(IN_SPLITS)
NEG_INF = -1e30
RMS_EPS = 1e-6

kernel_name = 'hybrid_natten_hgrn2_swa_moe_dit'


def rms_norm(x, w):
    xf = x.astype(jnp.float32)
    y = xf * lax.rsqrt(jnp.mean(xf * xf, axis=-1, keepdims=True) + RMS_EPS)
    return (y * w.astype(jnp.float32)).astype(x.dtype)


def modulation(cond, w, b):
    return jnp.split(jax.nn.silu(cond) @ w + b, 6, axis=-1)


def modulate(h, shift, scale):
    return h * (1 + scale) + shift


def rope_2d(x, row_pos, col_pos):
    half = x.shape[-1] // 2
    quarter = half // 2
    inv_freq = ROPE_THETA ** (-jnp.arange(quarter, dtype=jnp.float32) / quarter)

    def rotate(xp, pos):
        ang = pos[:, None] * inv_freq[None, :]
        cos = jnp.cos(ang)[None, :, None, :]
        sin = jnp.sin(ang)[None, :, None, :]
        x1 = xp[..., :quarter].astype(jnp.float32)
        x2 = xp[..., quarter:].astype(jnp.float32)
        return jnp.concatenate([x1 * cos - x2 * sin, x2 * cos + x1 * sin], axis=-1)

    out = jnp.concatenate([rotate(x[..., :half], row_pos), rotate(x[..., half:], col_pos)], axis=-1)
    return out.astype(x.dtype)


def context_attention(q, k, v, sink):
    B, L, H, Dh = q.shape
    Hkv = k.shape[2]
    G = H // Hkv
    qg = q.reshape(B, L, Hkv, G, Dh)
    s = jnp.einsum('blkgd,bmkd->bkglm', qg, k).astype(jnp.float32) * (Dh ** -0.5)
    if sink is not None:
        s_sink = jnp.broadcast_to(sink.astype(jnp.float32).reshape(1, Hkv, G, 1, 1), s.shape[:-1] + (1,))
        s = jnp.concatenate([s, s_sink], axis=-1)
    p = jax.nn.softmax(s, axis=-1)[..., :L].astype(v.dtype)
    o = jnp.einsum('bkglm,bmkd->blkgd', p, v)
    return o.reshape(B, L, H * Dh)


def neighbourhood_attention(q, k, v, kc, vc, rpb):
    B, T, H, Dh = q.shape
    rows = T // GRID_W
    kr = min(NA_ROWS, rows)
    ncb = GRID_W // NA_QCB
    r = np.arange(rows)
    row_idx = np.clip(r - kr // 2, 0, rows - kr)[:, None] + np.arange(kr)[None, :]
    qcol = np.arange(GRID_W).reshape(ncb, NA_QCB)
    col_lo = np.clip(qcol - NA_COLS // 2, 0, GRID_W - NA_COLS)
    blk_lo = np.minimum(col_lo[:, 0], GRID_W - NA_KCB)
    col_idx = blk_lo[:, None] + np.arange(NA_KCB)[None, :]
    key_col = col_idx[:, None, :]
    col_ok = (key_col >= col_lo[..., None]) & (key_col < col_lo[..., None] + NA_COLS)
    d_row = row_idx - r[:, None] + NA_ROWS - 1
    d_col = np.clip(key_col - qcol[..., None] + NA_COLS - 1, 0, 2 * NA_COLS - 2)
    bias = rpb[:, d_row[:, None, None, :, None], d_col[None, :, :, None, :]]

    kg = k.reshape(B, rows, GRID_W, H, Dh)
    vg = v.reshape(B, rows, GRID_W, H, Dh)
    gi_r = row_idx[:, :, None, None]
    gi_c = col_idx[None, None, :, :]
    k_nb = kg[:, gi_r, gi_c]
    v_nb = vg[:, gi_r, gi_c]
    qb = q.reshape(B, rows, ncb, NA_QCB, H, Dh)
    scale = Dh ** -0.5
    s_nb = jnp.einsum('brjqhd,brajmhd->bhrjqam', qb, k_nb).astype(jnp.float32) * scale + bias[None].astype(jnp.float32)
    s_nb = jnp.where(col_ok[:, :, None, :], s_nb, NEG_INF)
    n_nb = kr * NA_KCB
    s_nb = s_nb.reshape(B, H, rows, ncb, NA_QCB, n_nb)
    s_ctx = jnp.einsum('brjqhd,blhd->bhrjql', qb, kc).astype(jnp.float32) * scale
    p = jax.nn.softmax(jnp.concatenate([s_nb, s_ctx], axis=-1), axis=-1).astype(v.dtype)
    p_nb = p[..., :n_nb].reshape(B, H, rows, ncb, NA_QCB, kr, NA_KCB)
    o = (jnp.einsum('bhrjqam,brajmhd->brjqhd', p_nb, v_nb)
         + jnp.einsum('bhrjql,blhd->brjqhd', p[..., n_nb:], vc))
    return o.reshape(B, T, H * Dh)


def window_attention(q, k, v, kc, vc, sink):
    B, T, H, Dh = q.shape
    Hkv = k.shape[2]
    G = H // Hkv
    L = kc.shape[1]
    nb = T // WA_BLOCK
    qb = q.reshape(B, nb, WA_BLOCK, Hkv, G, Dh)

    def band(a):
        ap = jnp.pad(a, ((0, 0), (WA_BLOCK, WA_BLOCK), (0, 0), (0, 0))).reshape(B, nb + 2, WA_BLOCK, Hkv, Dh)
        return jnp.concatenate([ap[:, :-2], ap[:, 1:-1], ap[:, 2:]], axis=2)

    kb = band(k)
    vb = band(v)
    blk = np.arange(nb)[:, None, None] * WA_BLOCK
    qpos = blk + np.arange(WA_BLOCK)[None, :, None]
    kpos = blk - WA_BLOCK + np.arange(3 * WA_BLOCK)[None, None, :]
    ok = (np.abs(kpos - qpos) <= WA_WINDOW) & (kpos >= 0) & (kpos < T)
    scale = Dh ** -0.5
    s_loc = jnp.einsum('bnqkgd,bnmkd->bkgnqm', qb, kb).astype(jnp.float32) * scale
    s_loc = jnp.where(ok, s_loc, NEG_INF)
    s_ctx = jnp.einsum('bnqkgd,blkd->bkgnql', qb, kc).astype(jnp.float32) * scale
    s_sink = jnp.broadcast_to(sink.astype(jnp.float32).reshape(1, Hkv, G, 1, 1, 1), s_ctx.shape[:-1] + (1,))
    p = jax.nn.softmax(jnp.concatenate([s_loc, s_ctx, s_sink], axis=-1), axis=-1).astype(v.dtype)
    nloc = 3 * WA_BLOCK
    o = (jnp.einsum('bkgnqm,bnmkd->bnqkgd', p[..., :nloc], vb)
         + jnp.einsum('bkgnql,blkd->bnqkgd', p[..., nloc:nloc + L], vc))
    return o.reshape(B, T, H * Dh)


def gla_chunk_scan(q, k, v, log_f, s0):
    B, T, H, dk = q.shape
    dv = v.shape[-1]
    C = HG_CHUNK
    n = T // C

    def chunks(a):
        return a.reshape(B, n, C, H, a.shape[-1]).transpose(1, 0, 3, 2, 4)

    lower_tri = np.tril(np.ones((C, C), dtype=bool))[:, :, None]

    def step(S, inp):
        qc, kc, vc, gc = inp
        b = jnp.cumsum(gc, axis=2)
        diff = b[:, :, :, None, :] - b[:, :, None, :, :]
        decay = jnp.exp(jnp.where(lower_tri, diff, NEG_INF))
        att = jnp.einsum('bhik,bhijk,bhjk->bhij', qc, decay, kc)
        o = jnp.einsum('bhij,bhjv->bhiv', att, vc) + jnp.einsum('bhik,bhkv->bhiv', qc * jnp.exp(b), S)
        b_last = b[:, :, -1:, :]
        S_new = (jnp.exp(b_last[:, :, 0, :])[..., None] * S
                 + jnp.einsum('bhjk,bhjv->bhkv', kc * jnp.exp(b_last - b), vc))
        return S_new, o

    s_final, o = lax.scan(step, s0, (chunks(q), chunks(k), chunks(v), chunks(log_f)))
    return o.transpose(1, 0, 3, 2, 4).reshape(B, T, H, dv), s_final


def hgrn_lower_bounds(hg_lower):
    p = jax.nn.softmax(hg_lower.astype(jnp.float32), axis=1)
    return jnp.cumsum(p, axis=1) - p[:, :1]


def hgrn2_mixer(q, f_fwd, f_bwd, i, g, lb_fwd, lb_bwd, norm_w, n_ctx):
    B, N = q.shape[:2]
    qf = jax.nn.silu(q.astype(jnp.float32))
    vf = i.astype(jnp.float32)
    s0 = jnp.zeros((B, HG_HEADS, HG_DK, HG_DV), jnp.float32)
    outs = []
    for f_pre, lb, reverse in ((f_fwd, lb_fwd, False), (f_bwd, lb_bwd, True)):
        lbh = lb.reshape(HG_HEADS, HG_DK)
        f = lbh + (1.0 - lbh) * jax.nn.sigmoid(f_pre.astype(jnp.float32))
        k = 1.0 - f
        log_f = jnp.log(jnp.maximum(f, LOG_FLOOR))
        orient = (lambda a: jnp.flip(a, axis=1)) if reverse else (lambda a: a)
        seqs = (qf, k, vf, log_f)
        o_c, s_c = gla_chunk_scan(*[orient(a[:, :n_ctx]) for a in seqs], s0)
        o_l, _ = gla_chunk_scan(*[orient(a[:, n_ctx:]) for a in seqs], s_c)
        outs.append(jnp.concatenate([orient(o_c), orient(o_l)], axis=1))
    o = rms_norm(outs[0] + outs[1], norm_w) * jax.nn.silu(g.astype(jnp.float32))
    return o.reshape(B, N, HG_VW).astype(q.dtype)


def token_mixers(h, n_ctx, need_ctx, w_in, na_qn, na_kn, na_rpb, lb_fwd, lb_bwd, hg_norm,
                 wa_qn, wa_kn, wa_sink, w_pa, w_pb, w_pc, w_out, row_pos, col_pos):
    B, N, D = h.shape
    L = n_ctx
    cuts = np.cumsum(IN_SPLITS)[:-1].tolist()
    qa, ka, va, qh, fh_f, fh_b, ih, gh, qw, kw, vw, gates = jnp.split(h @ w_in, cuts, axis=-1)

    def heads(a, n):
        return a.reshape(B, N, n, -1)

    qa = rms_norm(heads(qa, NA_HEADS), na_qn)
    ka = rms_norm(heads(ka, NA_HEADS), na_kn)
    va = heads(va, NA_HEADS)
    y_a = neighbourhood_attention(qa[:, L:], ka[:, L:], va[:, L:], ka[:, :L], va[:, :L], na_rpb)
    y_b = hgrn2_mixer(heads(qh, HG_HEADS), heads(fh_f, HG_HEADS), heads(fh_b, HG_HEADS),
                      heads(ih, HG_HEADS), heads(gh, HG_HEADS), lb_fwd, lb_bwd, hg_norm, L)
    qw = rms_norm(heads(qw, WA_HEADS), wa_qn)
    kw = rms_norm(heads(kw, WA_KV_HEADS), wa_kn)
    vw = heads(vw, WA_KV_HEADS)
    y_c = window_attention(rope_2d(qw[:, L:], row_pos, col_pos), rope_2d(kw[:, L:], row_pos, col_pos),
                           vw[:, L:], kw[:, :L], vw[:, :L], wa_sink)
    if need_ctx:
        y_a = jnp.concatenate([context_attention(qa[:, :L], ka[:, :L], va[:, :L], None), y_a], axis=1)
        y_c = jnp.concatenate([context_attention(qw[:, :L], kw[:, :L], vw[:, :L], wa_sink), y_c], axis=1)
    else:
        y_b = y_b[:, L:]
        gates = gates[:, L:]
    g_a, g_b, g_c = jnp.split(jax.nn.sigmoid(gates), N_BRANCHES, axis=-1)
    merged = g_a * (y_a @ w_pa) + g_b * (y_b @ w_pb) + g_c * (y_c @ w_pc)
    return merged @ w_out


def moe_ffn(h, w_router, b_router, w_gate, w_up, w_down):
    N, D = h.shape
    probs = jax.nn.softmax((h @ w_router).astype(jnp.float32), axis=-1)
    sel = (probs + b_router.astype(jnp.float32)).reshape(N, N_GROUPS, EXPERTS_PER_GROUP)
    grp_score = lax.top_k(sel, TOP_K)[0].sum(-1)
    g_idx = jnp.argmax(grp_score, axis=-1)
    in_grp = jnp.take_along_axis(sel, g_idx[:, None, None], axis=1)[:, 0]
    _, loc = lax.top_k(in_grp, TOP_K)
    e_idx = g_idx[:, None] * EXPERTS_PER_GROUP + loc
    wts = jnp.take_along_axis(probs, e_idx, axis=1)
    wts = wts / jnp.sum(wts, axis=-1, keepdims=True)
    A = N * TOP_K
    flat_e = e_idx.reshape(A)
    flat_tok = jnp.repeat(jnp.arange(N), TOP_K)
    flat_w = wts.reshape(A)
    order = jnp.argsort(flat_e)
    se, st, sw = flat_e[order], flat_tok[order], flat_w[order]
    counts = jnp.bincount(flat_e, length=N_EXPERTS)
    padded = ((counts + MOE_BLOCK - 1) // MOE_BLOCK) * MOE_BLOCK
    pend = jnp.cumsum(padded)
    pstart = pend - padded
    start = jnp.cumsum(counts) - counts
    dest = pstart[se] + jnp.arange(A) - start[se]
    nblk = -(-A // MOE_BLOCK) + N_EXPERTS
    buf_tok = jnp.zeros((nblk * MOE_BLOCK,), jnp.int32).at[dest].set(st)
    blk_e = jnp.minimum(jnp.searchsorted(pend, jnp.arange(nblk) * MOE_BLOCK, side='right'), N_EXPERTS - 1)
    xb = h[buf_tok].reshape(nblk, MOE_BLOCK, D)

    def expert_block(args):
        xblk, e = args
        return (jax.nn.silu(xblk @ w_gate[e]) * (xblk @ w_up[e])) @ w_down[e]

    yb = lax.map(expert_block, (xb, blk_e)).reshape(nblk * MOE_BLOCK, D)
    y = yb[dest] * sw[:, None].astype(h.dtype)
    return jax.ops.segment_sum(y, st, num_segments=N)


def hybrid_layer(x, ctx, c, c_ctx, need_ctx, w_ada, b_ada, norm1, norm2, w_in, na_qn, na_kn, na_rpb,
                 lb_fwd, lb_bwd, hg_norm, wa_qn, wa_kn, wa_sink, w_pa, w_pb, w_pc, w_out,
                 w_router, b_router, w_gate, w_up, w_down, row_pos, col_pos):
    B, T, D = x.shape
    L = ctx.shape[1]
    m = modulation(c, w_ada, b_ada)
    mc = modulation(c_ctx, w_ada, b_ada)
    h = jnp.concatenate([modulate(rms_norm(ctx, norm1), mc[0], mc[1]),
                         modulate(rms_norm(x, norm1), m[0][:, None], m[1][:, None])], axis=1)
    mix = token_mixers(h, L, need_ctx, w_in, na_qn, na_kn, na_rpb, lb_fwd, lb_bwd, hg_norm,
                       wa_qn, wa_kn, wa_sink, w_pa, w_pb, w_pc, w_out, row_pos, col_pos)
    if need_ctx:
        ctx = ctx + mc[2] * mix[:, :L]
        x = x + m[2][:, None] * mix[:, L:]
        hc = modulate(rms_norm(ctx, norm2), mc[3], mc[4])
        hx = modulate(rms_norm(x, norm2), m[3][:, None], m[4][:, None])
        y = moe_ffn(jnp.concatenate([hc, hx], axis=1).reshape(-1, D), w_router, b_router,
                    w_gate, w_up, w_down).reshape(B, L + T, D)
        ctx = ctx + mc[5] * y[:, :L]
        x = x + m[5][:, None] * y[:, L:]
    else:
        x = x + m[2][:, None] * mix
        hx = modulate(rms_norm(x, norm2), m[3][:, None], m[4][:, None])
        y = moe_ffn(hx.reshape(-1, D), w_router, b_router, w_gate, w_up, w_down).reshape(B, T, D)
        x = x + m[5][:, None] * y
    return x, ctx


def setup_inputs(seed: int = 0) -> dict:
    key = jax.random.key(seed)
    ks = jax.random.split(key, 26)
    f32 = jnp.float32
    D = D_MODEL

    def nrm(k, shape, scale):
        return jax.random.normal(k, shape, f32) * scale

    return {
        'x': nrm(ks[0], (BATCH, SEQ, D), 1.0),
        'c': nrm(ks[1], (BATCH, D), 1.0),
        'ctx': nrm(ks[2], (BATCH, CTX_LEN, D), 1.0),
        'c_ctx': nrm(ks[3], (D,), 1.0),
        'w_ada': nrm(ks[4], (DEPTH, D, 6 * D), 0.5 * D ** -0.5),
        'b_ada': nrm(ks[5], (DEPTH, 6 * D), 0.01),
        'norm1': 1.0 + nrm(ks[6], (DEPTH, D), 0.01),
        'norm2': 1.0 + nrm(ks[7], (DEPTH, D), 0.01),
        'w_in': nrm(ks[8], (DEPTH, D, IN_COLS), D ** -0.5),
        'na_q_norm': 1.0 + nrm(ks[9], (DEPTH, NA_HEAD_DIM), 0.01),
        'na_k_norm': 1.0 + nrm(ks[10], (DEPTH, NA_HEAD_DIM), 0.01),
        'na_rpb': nrm(ks[11], (DEPTH, NA_HEADS, 2 * NA_ROWS - 1, 2 * NA_COLS - 1), 0.2),
        'hg_lower': nrm(ks[12], (2, DEPTH, HG_KW), 1.0),
        'hg_norm': 1.0 + nrm(ks[13], (DEPTH, HG_DV), 0.01),
        'wa_q_norm': 1.0 + nrm(ks[14], (DEPTH, WA_HEAD_DIM), 0.01),
        'wa_k_norm': 1.0 + nrm(ks[15], (DEPTH, WA_HEAD_DIM), 0.01),
        'wa_sink': nrm(ks[16], (DEPTH, WA_HEADS), 1.0),
        'w_pa': nrm(ks[17], (DEPTH, NA_W, D), NA_W ** -0.5),
        'w_pb': nrm(ks[18], (DEPTH, HG_VW, D), HG_VW ** -0.5),
        'w_pc': nrm(ks[19], (DEPTH, WA_QW, D), WA_QW ** -0.5),
        'w_out': nrm(ks[20], (DEPTH, D, D), D ** -0.5),
        'w_router': nrm(ks[21], (D, N_EXPERTS), D ** -0.5),
        'b_router': nrm(ks[22], (N_EXPERTS,), 0.01),
        'w_gate': nrm(ks[23], (DEPTH, N_EXPERTS, D, EXPERT_FF), D ** -0.5),
        'w_up': nrm(ks[24], (DEPTH, N_EXPERTS, D, EXPERT_FF), D ** -0.5),
        'w_down': nrm(ks[25], (DEPTH, N_EXPERTS, EXPERT_FF, D), EXPERT_FF ** -0.5),
    }


def reference(x, c, ctx, c_ctx, w_ada, b_ada, norm1, norm2, w_in, na_q_norm, na_k_norm, na_rpb, hg_lower,
              hg_norm, wa_q_norm, wa_k_norm, wa_sink, w_pa, w_pb, w_pc, w_out, w_router, b_router,
              w_gate, w_up, w_down):
    T = x.shape[1]
    pos = jnp.arange(T)
    row_pos = (pos // GRID_W).astype(jnp.float32)
    col_pos = (pos % GRID_W).astype(jnp.float32)
    lb = hgrn_lower_bounds(hg_lower)
    for l in range(DEPTH):
        x, ctx = hybrid_layer(x, ctx, c, c_ctx, l < DEPTH - 1, w_ada[l], b_ada[l], norm1[l], norm2[l], w_in[l],
                              na_q_norm[l], na_k_norm[l], na_rpb[l], lb[0, l], lb[1, l], hg_norm[l],
                              wa_q_norm[l], wa_k_norm[l], wa_sink[l], w_pa[l], w_pb[l], w_pc[l], w_out[l],
                              w_router, b_router, w_gate[l], w_up[l], w_down[l], row_pos, col_pos)
    return x
```

```cpp
#include <hip/hip_runtime.h>
#include <cstdio>
#include <cstdint>

#define DI __device__ __forceinline__
typedef unsigned short bf16_t;
typedef short bf16x8 __attribute__((ext_vector_type(8)));
typedef short s16x4 __attribute__((ext_vector_type(4)));
typedef float f32x2 __attribute__((ext_vector_type(2)));
typedef float f32x4 __attribute__((ext_vector_type(4)));
typedef float f32x16 __attribute__((ext_vector_type(16)));
typedef unsigned u32x2 __attribute__((ext_vector_type(2)));
typedef unsigned u32x4 __attribute__((ext_vector_type(4)));
typedef __bf16 bf16x2_t __attribute__((ext_vector_type(2)));

constexpr int NB = 2, T = 8192, L = 256, NT = L + T, NTOK = NB * NT, D = 1024;
constexpr int INC = 7936;
constexpr int PCOLS = 4864;
constexpr int NCHUNK = NT / 64;
constexpr int NCHAIN = 16;
constexpr int NASSIGN = NTOK * 2;
constexpr float RMS_EPS = 1e-6f;
constexpr float LOG2E = 1.4426950408889634f;
constexpr int NTHREADS = 512;
constexpr int LDS_BYTES = 135168;

constexpr size_t al256(size_t x) { return (x + 255) & ~(size_t)255; }
constexpr size_t WS_CTL = 0;
constexpr size_t CTL_BYTES = 16384;
constexpr size_t WS_MOD = CTL_BYTES;
constexpr size_t WS_ROPE = al256(WS_MOD + 2 * 3 * 6144 * 4);
constexpr size_t WS_LB = al256(WS_ROPE + 2 * 128 * 16 * 4);
constexpr size_t WS_CNT = WS_CTL + 3456 * 4;
constexpr size_t WS_CTXR = al256(WS_LB + 2 * 2 * 512 * 4);
constexpr size_t WS_LIST = al256(WS_CTXR + (size_t)NB * L * D * 4);
constexpr size_t WS_WTS = al256(WS_LIST + (size_t)16 * NTOK * 4);
constexpr size_t WS_DEC = al256(WS_WTS + (size_t)NASSIGN * 4);
constexpr size_t WS_H = al256(WS_DEC + (size_t)NCHAIN * NCHUNK * 128 * 4);
constexpr size_t WS_Y = al256(WS_H + (size_t)NTOK * D * 2);
constexpr size_t WS_U = al256(WS_Y + (size_t)3 * NTOK * 512 * 2);
constexpr size_t WMIX_BYTES = (size_t)(PCOLS + 3072 + 1024) * D * 2 + (size_t)3 * 1024 * 512 * 2;
constexpr size_t WEXP_BYTES = (size_t)16 * (1024 * 1024 + 1024 * 512) * 2;
constexpr size_t WS_WMIX = al256(WS_U + (size_t)NCHAIN * NCHUNK * 16384 * 2);
constexpr size_t WS_WEXP = al256(WS_WMIX + WMIX_BYTES);
constexpr size_t WS_P = al256(WS_WEXP + WEXP_BYTES);
constexpr size_t WS_QA = WS_P;
constexpr size_t WS_KA = al256(WS_QA + (size_t)NTOK * 512 * 2);
constexpr size_t WS_VAT = al256(WS_KA + (size_t)NTOK * 512 * 2);
constexpr size_t WS_HG = al256(WS_VAT + (size_t)NTOK * 512 * 2);
constexpr size_t WS_QW = al256(WS_HG + (size_t)NTOK * 2560 * 2);
constexpr size_t WS_KW = al256(WS_QW + (size_t)NTOK * 512 * 2);
constexpr size_t WS_VWT = al256(WS_KW + (size_t)NTOK * 128 * 2);
constexpr size_t WS_PEND = al256(WS_VWT + (size_t)NTOK * 128 * 2);
constexpr size_t WS_G = WS_P;
constexpr size_t WS_MERGED = al256(WS_G + (size_t)NTOK * 3072 * 2);
constexpr size_t WS_MEND = al256(WS_MERGED + (size_t)NTOK * D * 2);
constexpr size_t WS_HX = WS_P;
constexpr size_t WS_ACT = al256(WS_HX + (size_t)NTOK * D * 2);
constexpr size_t WS_ACTEND = al256(WS_ACT + (size_t)(NASSIGN + 16 * 256) * 512 * 2);
static_assert(WS_MEND <= WS_PEND && WS_ACTEND <= WS_PEND, "P overlays");
constexpr size_t WS_YS = WS_U;
constexpr size_t WS_TOTAL = WS_PEND;
static_assert(WS_TOTAL < 400ull * 1000 * 1000, "workspace too large");
static_assert((size_t)NASSIGN * 1024 * 2 <= (size_t)NCHAIN * NCHUNK * 16384 * 2, "YS overlay");

struct Params {
  const float *x, *c, *ctx, *c_ctx, *w_ada, *b_ada, *norm1, *norm2, *w_in, *na_qn, *na_kn, *na_rpb, *hg_lower, *hg_norm,
      *wa_qn, *wa_kn, *wa_sink, *w_pa, *w_pb, *w_pc, *w_out, *w_router, *b_router, *w_gate, *w_up, *w_down;
  float* out;
  unsigned char* ws;
};

DI unsigned pk2(float lo, float hi) { f32x2 v = {lo, hi}; bf16x2_t r = __builtin_convertvector(v, bf16x2_t); return __builtin_bit_cast(unsigned, r); }
DI float bf_lo(unsigned u) { return __uint_as_float(u << 16); }
DI float bf_hi(unsigned u) { return __uint_as_float(u & 0xffff0000u); }
DI float bf2f(bf16_t h) { return __uint_as_float(((unsigned)h) << 16); }
DI bf16_t f2bf(float x) { return (bf16_t)(pk2(x, 0.f) & 0xffffu); }
DI int launder_tid() { int t = threadIdx.x; asm volatile("" : "+v"(t)); return t; }
DI int crow(int reg, int h) { return (reg & 3) + 8 * (reg >> 2) + 4 * h; }
DI float wave_sum(float v) {
#pragma unroll
  for (int o = 32; o >= 1; o >>= 1) v += __shfl_xor(v, o);
  return v;
}
DI float silu_f(float x) { return x / (1.f + __expf(-x)); }
DI float sigmoid_f(float x) { return 1.f / (1.f + __expf(-x)); }
DI f32x16 zero16() { f32x16 z; for (int i = 0; i < 16; ++i) z[i] = 0.f; return z; }
DI void lds_sync() { asm volatile("s_waitcnt lgkmcnt(0)\n\ts_barrier" ::: "memory"); }
#define MFMA32(a, b, c) __builtin_amdgcn_mfma_f32_32x32x16_bf16((a), (b), (c), 0, 0, 0)
#define MFMA16(a, b, c) __builtin_amdgcn_mfma_f32_16x16x32_bf16((a), (b), (c), 0, 0, 0)


#define LAS __attribute__((address_space(3)))
#define XB_TMO      128
#define XB_XCNT(j)  (256  + 64 * (j))
#define XB_XSUB(j)  (1280 + 64 * (j))
#define XB_XGEN(j)  (2304 + 64 * (j))
#define XB_TOP      3328
#define XB_TOPGEN   3392
#define XCD_BAR_WORDS 3456
#define XB_SPIN_CAP (1u << 18)
DI unsigned xb_ld(unsigned* p) { return __hip_atomic_load(p, __ATOMIC_RELAXED, __HIP_MEMORY_SCOPE_AGENT); }
DI unsigned xb_add(unsigned* p, unsigned v) { return __hip_atomic_fetch_add(p, v, __ATOMIC_RELAXED, __HIP_MEMORY_SCOPE_AGENT); }
DI unsigned xb_xcc_id() { return (unsigned)__builtin_amdgcn_s_getreg((3 << 11) | 20) & 0xFu; }
#define XB_SPIN(cond, bar) do { unsigned _sp = 0; while (cond) { __builtin_amdgcn_s_sleep(1); \
    if ((++_sp & 255u) == 0u) { if (xb_ld(&(bar)[XB_TMO])) break; if (_sp > XB_SPIN_CAP) { atomicAdd(&(bar)[XB_TMO], 1u); break; } } } } while (0)
struct XcdBarrier { unsigned* bar; unsigned x; volatile LAS unsigned* st; };
DI XcdBarrier xcd_barrier_post(unsigned* bar, volatile LAS unsigned* st) {
  XcdBarrier b; b.bar = bar; b.x = xb_xcc_id(); b.st = st;
  if (threadIdx.x == 0) (void)xb_add(&bar[XB_XCNT(b.x)], 1u);
  return b;
}
DI void xcd_barrier_complete(unsigned* bar, unsigned x, unsigned& nloc, unsigned& nx) {
  const unsigned G = gridDim.x * gridDim.y * gridDim.z;
  unsigned sum, cnt, mine, sp = 0u;
  for (;;) {
    sum = 0u; cnt = 0u; mine = 0u;
#pragma unroll
    for (unsigned j = 0; j < 16; ++j) { const unsigned c = xb_ld(&bar[XB_XCNT(j)]); sum += c; cnt += (c > 0u) ? 1u : 0u; mine = (j == x) ? c : mine; }
    if (sum == G) break;
    __builtin_amdgcn_s_sleep(1);
    if ((++sp & 255u) == 0u) { if (xb_ld(&bar[XB_TMO])) break; if (sp > XB_SPIN_CAP) { atomicAdd(&bar[XB_TMO], 1u); break; } }
  }
  nloc = mine > 0u ? mine : 1u; nx = cnt > 0u ? cnt : 1u;
}
DI void xcd_barrier(const XcdBarrier& b) {
  asm volatile("s_waitcnt vmcnt(0)" ::: "memory");
  __syncthreads();
  if (threadIdx.x == 0) {
    unsigned* bar = b.bar;
    const unsigned bx = xb_xcc_id();
    __builtin_amdgcn_s_waitcnt(0);
    unsigned nloc = b.st[0], nx = b.st[1];
    if (nloc == 0u) { xcd_barrier_complete(bar, bx, nloc, nx); b.st[0] = nloc; b.st[1] = nx; }
    const unsigned old = xb_add(&bar[XB_XSUB(bx)], 1u);
    const unsigned gen = old / nloc;
    if (old + 1u == (gen + 1u) * nloc) {
      __builtin_amdgcn_fence(__ATOMIC_RELEASE, "agent");
      asm volatile("s_waitcnt vmcnt(0)" ::: "memory");
      const unsigned og = xb_add(&bar[XB_TOP], 1u);
      const unsigned tg = og / nx;
      if (og + 1u == (tg + 1u) * nx) xb_add(&bar[XB_TOPGEN], 1u);
      else XB_SPIN(xb_ld(&bar[XB_TOPGEN]) == tg, bar);
      __builtin_amdgcn_fence(__ATOMIC_ACQUIRE, "agent");
      xb_add(&bar[XB_XGEN(bx)], 1u);
      asm volatile("s_waitcnt vmcnt(0)" ::: "memory");
    } else {
      XB_SPIN(xb_ld(&bar[XB_XGEN(bx)]) == gen, bar);
      __builtin_amdgcn_fence(__ATOMIC_ACQUIRE, "agent");
      asm volatile("s_waitcnt vmcnt(0)" ::: "memory");
    }
  }
  __syncthreads();
}

DI const float* res_in_row(const Params& p, int layer, int g) {
  const int b = g / NT, n = g - b * NT;
  if (layer == 0) return n < L ? p.ctx + ((size_t)b * L + n) * D : p.x + ((size_t)b * T + (n - L)) * D;
  return n < L ? (const float*)(p.ws + WS_CTXR) + ((size_t)b * L + n) * D : p.out + ((size_t)b * T + (n - L)) * D;
}
DI float* res_out_row(const Params& p, int g) {
  const int b = g / NT, n = g - b * NT;
  return n < L ? (float*)(p.ws + WS_CTXR) + ((size_t)b * L + n) * D : p.out + ((size_t)b * T + (n - L)) * D;
}
DI int mod_vec(int g) { const int b = g / NT, n = g - b * NT; return n < L ? 2 : b; }
DI const float* mod_ptr(const Params& p, int layer, int v, int chunk) { return (const float*)(p.ws + WS_MOD) + ((size_t)(layer * 3 + v) * 6 + chunk) * D; }

__device__ void phase_p0(const Params& p, unsigned char* smem) {
  const int tid = launder_tid();
  float* sc = (float*)smem;
  float* red = sc + 3 * 1024;
  for (int i = tid; i < 3 * 1024; i += NTHREADS) {
    const int v = i >> 10, d = i & 1023;
    const float x = v == 0 ? p.c[d] : (v == 1 ? p.c[1024 + d] : p.c_ctx[d]);
    sc[i] = silu_f(x);
  }
  __syncthreads();
  for (int u = blockIdx.x; u < 2 * 96; u += gridDim.x) {
    const int layer = u / 96, j0 = (u % 96) * 64;
    const int col = tid & 63, ds = tid >> 6;
    const float* w = p.w_ada + ((size_t)layer * D + ds * 128) * 6144 + j0 + col;
    float a0 = 0.f, a1 = 0.f, a2 = 0.f;
#pragma unroll 8
    for (int d = 0; d < 128; ++d) {
      const float wv = w[(size_t)d * 6144];
      a0 += sc[ds * 128 + d] * wv; a1 += sc[1024 + ds * 128 + d] * wv; a2 += sc[2048 + ds * 128 + d] * wv;
    }
    red[(ds * 64 + col) * 3 + 0] = a0; red[(ds * 64 + col) * 3 + 1] = a1; red[(ds * 64 + col) * 3 + 2] = a2;
    __syncthreads();
    if (tid < 192) {
      const int v = tid / 64, cc = tid & 63;
      float s = p.b_ada[layer * 6144 + j0 + cc];
      for (int k = 0; k < 8; ++k) s += red[(k * 64 + cc) * 3 + v];
      ((float*)(p.ws + WS_MOD))[(size_t)(layer * 3 + v) * 6144 + j0 + cc] = s;
    }
    __syncthreads();
  }
  const int gt = blockIdx.x * NTHREADS + tid, nth = gridDim.x * NTHREADS;
  float* rope = (float*)(p.ws + WS_ROPE);
  for (int i = gt; i < 128 * 16; i += nth) {
    const int pos = i >> 4, k = i & 15;
    const float inv = powf(10000.0f, -(float)k / 16.0f);
    float sn, cs; sincosf((float)pos * inv, &sn, &cs);
    rope[i] = cs; rope[2048 + i] = sn;
  }
  float* lb = (float*)(p.ws + WS_LB);
  for (int i = gt; i < 2 * 2 * 512; i += nth) {
    const int layer = i >> 10, dir = (i >> 9) & 1, ch = i & 511;
    const float h0 = p.hg_lower[(dir * 2 + 0) * 512 + ch], h1 = p.hg_lower[(dir * 2 + 1) * 512 + ch];
    lb[i] = layer == 0 ? 0.f : 1.f / (1.f + expf(h0 - h1));
  }
}

__device__ void phase_a0(const Params& p, int layer) {
  const int tid_ = launder_tid(), lane = tid_ & 63, wave = tid_ >> 6;
  const float* nw = p.norm1 + layer * D;
  bf16_t* H = (bf16_t*)(p.ws + WS_H);
  const bf16_t* YS = (const bf16_t*)(p.ws + WS_YS);
  for (int g = blockIdx.x * 8 + wave; g < NTOK; g += gridDim.x * 8) {
    const float* src = res_in_row(p, layer, g);
    const int v = mod_vec(g);
    f32x4 x[4];
#pragma unroll
    for (int i = 0; i < 4; ++i) x[i] = *(const f32x4*)(src + (i * 64 + lane) * 4);
    if (layer > 0) {
      const float* g5 = mod_ptr(p, layer - 1, v, 5);
      float* dst = res_out_row(p, g);
#pragma unroll
      for (int i = 0; i < 4; ++i) {
        const int col = (i * 64 + lane) * 4;
        const u32x2 y0 = *(const u32x2*)(YS + (size_t)(2 * g) * D + col), y1 = *(const u32x2*)(YS + (size_t)(2 * g + 1) * D + col);
        const f32x4 gg = *(const f32x4*)(g5 + col);
        x[i][0] += gg[0] * (bf_lo(y0[0]) + bf_lo(y1[0])); x[i][1] += gg[1] * (bf_hi(y0[0]) + bf_hi(y1[0]));
        x[i][2] += gg[2] * (bf_lo(y0[1]) + bf_lo(y1[1])); x[i][3] += gg[3] * (bf_hi(y0[1]) + bf_hi(y1[1]));
        *(f32x4*)(dst + col) = x[i];
      }
    }
    float ss = 0.f;
#pragma unroll
    for (int i = 0; i < 4; ++i) ss += x[i][0] * x[i][0] + x[i][1] * x[i][1] + x[i][2] * x[i][2] + x[i][3] * x[i][3];
    ss = wave_sum(ss);
    const float r = rsqrtf(ss * (1.f / D) + RMS_EPS);
    const float* sh = mod_ptr(p, layer, v, 0);
    const float* scl = mod_ptr(p, layer, v, 1);
#pragma unroll
    for (int i = 0; i < 4; ++i) {
      const int col = (i * 64 + lane) * 4;
      const f32x4 w4 = *(const f32x4*)(nw + col), s4 = *(const f32x4*)(sh + col), c4 = *(const f32x4*)(scl + col);
      float y[4];
#pragma unroll
      for (int k = 0; k < 4; ++k) y[k] = x[i][k] * r * w4[k] * (1.f + c4[k]) + s4[k];
      u32x2 o; o[0] = pk2(y[0], y[1]); o[1] = pk2(y[2], y[3]);
      *(u32x2*)(H + (size_t)g * D + col) = o;
    }
  }
}


struct AttnSt { f32x16 o0, o1; float m, l; };
DI void attn_init(AttnSt& st) { st.o0 = zero16(); st.o1 = zero16(); st.m = -1e30f; st.l = 0.f; }
DI void load_q(bf16x8 (&qf)[4], const bf16_t* qp) {
#pragma unroll
  for (int ks = 0; ks < 4; ++ks) qf[ks] = *(const bf16x8*)(qp + ks * 16);
}
DI void load_kv(bf16x8 (&kf)[4], u32x4 (&vf)[2][2], const bf16_t* kp  , const bf16_t* vp  ) {
#pragma unroll
  for (int ks = 0; ks < 4; ++ks) kf[ks] = *(const bf16x8*)(kp + ks * 16);
#pragma unroll
  for (int ks = 0; ks < 2; ++ks)
#pragma unroll
    for (int dt = 0; dt < 2; ++dt) {
      const u32x2 lo = *(const u32x2*)(vp + (size_t)dt * 32 * NT + ks * 16), hi = *(const u32x2*)(vp + (size_t)dt * 32 * NT + ks * 16 + 8);
      vf[ks][dt][0] = lo[0]; vf[ks][dt][1] = lo[1]; vf[ks][dt][2] = hi[0]; vf[ks][dt][3] = hi[1];
    }
}
DI f32x16 qk_tile(const bf16x8 (&kf)[4], const bf16x8 (&qf)[4]) {
  f32x16 s = zero16();
#pragma unroll
  for (int ks = 0; ks < 4; ++ks) s = MFMA32(kf[ks], qf[ks], s);
  return s;
}
DI void softmax_pv(AttnSt& st, const f32x16& s, const u32x4 (&vf)[2][2]) {
  float tm = s[0];
#pragma unroll
  for (int r = 1; r < 16; ++r) tm = fmaxf(tm, s[r]);
  tm = fmaxf(tm, __shfl_xor(tm, 32));
  const float mn = fmaxf(st.m, tm);
  const float alpha = __builtin_amdgcn_exp2f(st.m - mn);
  float pv[16]; float rs = 0.f;
#pragma unroll
  for (int r = 0; r < 16; ++r) { pv[r] = __builtin_amdgcn_exp2f(s[r] - mn); rs += pv[r]; }
  rs += __shfl_xor(rs, 32);
  st.l = st.l * alpha + rs; st.m = mn;
#pragma unroll
  for (int r = 0; r < 16; ++r) { st.o0[r] *= alpha; st.o1[r] *= alpha; }
#pragma unroll
  for (int ks = 0; ks < 2; ++ks) {
    u32x4 pp; pp[0] = pk2(pv[8 * ks], pv[8 * ks + 1]); pp[1] = pk2(pv[8 * ks + 2], pv[8 * ks + 3]); pp[2] = pk2(pv[8 * ks + 4], pv[8 * ks + 5]); pp[3] = pk2(pv[8 * ks + 6], pv[8 * ks + 7]);
    const bf16x8 pf = __builtin_bit_cast(bf16x8, pp);
    st.o0 = MFMA32(__builtin_bit_cast(bf16x8, vf[ks][0]), pf, st.o0);
    st.o1 = MFMA32(__builtin_bit_cast(bf16x8, vf[ks][1]), pf, st.o1);
  }
}
DI void attn_store(const AttnSt& st, bf16_t* dst, int h) {
  const float inv = 1.f / st.l;
#pragma unroll
  for (int q = 0; q < 4; ++q) {
    u32x2 o; o[0] = pk2(st.o0[4 * q] * inv, st.o0[4 * q + 1] * inv); o[1] = pk2(st.o0[4 * q + 2] * inv, st.o0[4 * q + 3] * inv);
    *(u32x2*)(dst + 8 * q + 4 * h) = o;
    u32x2 o2; o2[0] = pk2(st.o1[4 * q] * inv, st.o1[4 * q + 1] * inv); o2[1] = pk2(st.o1[4 * q + 2] * inv, st.o1[4 * q + 3] * inv);
    *(u32x2*)(dst + 32 + 8 * q + 4 * h) = o2;
  }
}
DI void attn_sink(AttnSt& st, float sk) {
  const float mf = fmaxf(st.m, sk), a = __builtin_amdgcn_exp2f(st.m - mf);
  st.l = st.l * a + __builtin_amdgcn_exp2f(sk - mf); st.m = mf;
#pragma unroll
  for (int rg = 0; rg < 16; ++rg) { st.o0[rg] *= a; st.o1[rg] *= a; }
}
DI void scale_plain(f32x16& s) {
#pragma unroll
  for (int r = 0; r < 16; ++r) s[r] *= 0.125f * LOG2E;
}
DI void attn_ctx_tiles2(AttnSt& sa, AttnSt& sb, const bf16x8 (&qa)[4], const bf16x8 (&qb)[4], const bf16_t* kbase, int kstride, const bf16_t* vbase, int lane) {
  const int h = lane >> 5, ql = lane & 31;
#pragma unroll 1
  for (int i = 0; i < 8; ++i) {
    bf16x8 kf[4]; u32x4 vf[2][2];
    load_kv(kf, vf, kbase + (size_t)(32 * i + ql) * kstride + 8 * h, vbase + (size_t)ql * NT + 32 * i + 4 * h);
    f32x16 s0 = qk_tile(kf, qa), s1 = qk_tile(kf, qb);
    scale_plain(s0); scale_plain(s1);
    softmax_pv(sa, s0, vf); softmax_pv(sb, s1, vf);
  }
}

__device__ void phase_attn(const Params& p, int layer, unsigned char* smem) {
  const int tid_ = launder_tid(), lane = tid_ & 63, wave = tid_ >> 6, h = lane >> 5, ql = lane & 31;
  const bf16_t* QA = (const bf16_t*)(p.ws + WS_QA); const bf16_t* KA = (const bf16_t*)(p.ws + WS_KA); const bf16_t* VAT = (const bf16_t*)(p.ws + WS_VAT);
  const bf16_t* QW = (const bf16_t*)(p.ws + WS_QW); const bf16_t* KW = (const bf16_t*)(p.ws + WS_KW); const bf16_t* VWT = (const bf16_t*)(p.ws + WS_VWT);
  bf16_t* YA = (bf16_t*)(p.ws + WS_Y); bf16_t* YC = YA + (size_t)2 * NTOK * 512;
  const float NEG_INF = -__builtin_inff();
  constexpr int NU_NA = NB * 8 * 128, NU_WA = NB * 2 * (T / 32) * 2, NU_C = NB * 8 * 4;
  const int nunits = NU_NA + NU_WA + (layer == 0 ? 2 * NU_C : 0);
#pragma unroll 1
  for (int u = blockIdx.x * 8 + wave; u < nunits; u += gridDim.x * 8) {
    AttnSt sa, sb; attn_init(sa); attn_init(sb);
    bf16x8 qa[4], qb[4];
    if (u < NU_NA) {
      const int r = u & 127, head = (u >> 7) & 7, b = u >> 10;
      const int gq = b * NT + L + r * 64 + ql;
      load_q(qa, QA + (size_t)gq * 512 + head * 64 + 8 * h);
      load_q(qb, QA + (size_t)(gq + 32) * 512 + head * 64 + 8 * h);
      const bf16_t* kb = KA + (size_t)b * NT * 512 + head * 64;
      const bf16_t* vb = VAT + (size_t)(b * 8 + head) * 64 * NT;
      const int rs = min(max(r - 4, 0), 120);
      const int cqa = ql, cqb = 32 + ql;
      const int loa = min(max(cqa - 8, 0), 48), lob = min(max(cqb - 8, 0), 48);
      float* rpb = (float*)(smem + wave * 2048);
      { const float* rg_ = p.na_rpb + (size_t)(layer * 8 + head) * 15 * 31;
#pragma unroll
        for (int i_ = 0; i_ < 8; ++i_) { const int j_ = lane + 64 * i_; if (j_ < 465) rpb[j_] = rg_[j_]; } }
#pragma unroll 1
      for (int t = 0; t < 16; ++t) {
        const int kr = rs + (t >> 1), half = t & 1;
        const int n0 = L + kr * 64 + half * 32;
        bf16x8 kf[4]; u32x4 vf[2][2];
        load_kv(kf, vf, kb + (size_t)(n0 + ql) * 512 + 8 * h, vb + (size_t)ql * NT + n0 + 4 * h);
        const float* brow = rpb + (kr - r + 7) * 31;
        f32x16 s0 = qk_tile(kf, qa), s1 = qk_tile(kf, qb);
#pragma unroll
        for (int rg = 0; rg < 16; ++rg) {
          const int kc = half * 32 + crow(rg, h);
          const bool oka = kc >= loa && kc < loa + 16, okb = kc >= lob && kc < lob + 16;
          const float ba = brow[min(max(kc - cqa + 15, 0), 30)], bb = brow[min(max(kc - cqb + 15, 0), 30)];
          s0[rg] = oka ? (s0[rg] * 0.125f + ba) * LOG2E : NEG_INF;
          s1[rg] = okb ? (s1[rg] * 0.125f + bb) * LOG2E : NEG_INF;
        }
        softmax_pv(sa, s0, vf); softmax_pv(sb, s1, vf);
      }
      attn_ctx_tiles2(sa, sb, qa, qb, kb, 512, vb, lane);
      attn_store(sa, YA + (size_t)gq * 512 + head * 64, h);
      attn_store(sb, YA + (size_t)(gq + 32) * 512 + head * 64, h);
    } else if (u < NU_NA + NU_WA) {
      const int uu = u - NU_NA;
      const int qt = uu & 255, hp = (uu >> 8) & 1, kv = (uu >> 9) & 1, b = uu >> 10;
      const int ha = kv * 4 + hp * 2, hb = ha + 1;
      const int q0 = qt * 32, gq = b * NT + L + q0 + ql;
      load_q(qa, QW + (size_t)gq * 512 + ha * 64 + 8 * h);
      load_q(qb, QW + (size_t)gq * 512 + hb * 64 + 8 * h);
      const bf16_t* kb = KW + (size_t)b * NT * 128 + kv * 64;
      const bf16_t* vb = VWT + (size_t)(b * 2 + kv) * 64 * NT;
#pragma unroll 1
      for (int i = 0; i < 9; ++i) {
        const int k0 = q0 - 128 + 32 * i;
        if (k0 < 0 || k0 >= T) continue;
        bf16x8 kf[4]; u32x4 vf[2][2];
        load_kv(kf, vf, kb + (size_t)(L + k0 + ql) * 128 + 8 * h, vb + (size_t)ql * NT + L + k0 + 4 * h);
        f32x16 s0 = qk_tile(kf, qa), s1 = qk_tile(kf, qb);
#pragma unroll
        for (int rg = 0; rg < 16; ++rg) {
          const int dlt = (k0 + crow(rg, h)) - (q0 + ql);
          const bool ok = dlt <= 128 && dlt >= -128;
          s0[rg] = ok ? s0[rg] * (0.125f * LOG2E) : NEG_INF;
          s1[rg] = ok ? s1[rg] * (0.125f * LOG2E) : NEG_INF;
        }
        softmax_pv(sa, s0, vf); softmax_pv(sb, s1, vf);
      }
      attn_ctx_tiles2(sa, sb, qa, qb, kb, 128, vb, lane);
      attn_sink(sa, p.wa_sink[layer * 8 + ha] * LOG2E); attn_sink(sb, p.wa_sink[layer * 8 + hb] * LOG2E);
      attn_store(sa, YC + (size_t)gq * 512 + ha * 64, h);
      attn_store(sb, YC + (size_t)gq * 512 + hb * 64, h);
    } else if (u < NU_NA + NU_WA + NU_C) {
      const int uu = u - NU_NA - NU_WA;
      const int qp = uu & 3, head = (uu >> 2) & 7, b = uu >> 5;
      const int gq = b * NT + qp * 64 + ql;
      load_q(qa, QA + (size_t)gq * 512 + head * 64 + 8 * h);
      load_q(qb, QA + (size_t)(gq + 32) * 512 + head * 64 + 8 * h);
      attn_ctx_tiles2(sa, sb, qa, qb, KA + (size_t)b * NT * 512 + head * 64, 512, VAT + (size_t)(b * 8 + head) * 64 * NT, lane);
      attn_store(sa, YA + (size_t)gq * 512 + head * 64, h);
      attn_store(sb, YA + (size_t)(gq + 32) * 512 + head * 64, h);
    } else {
      const int uu = u - NU_NA - NU_WA - NU_C;
      const int qt = uu & 7, hp = (uu >> 3) & 1, kv = (uu >> 4) & 1, b = uu >> 5;
      const int ha = kv * 4 + hp * 2, hb = ha + 1;
      const int gq = b * NT + qt * 32 + ql;
      load_q(qa, QW + (size_t)gq * 512 + ha * 64 + 8 * h);
      load_q(qb, QW + (size_t)gq * 512 + hb * 64 + 8 * h);
      attn_ctx_tiles2(sa, sb, qa, qb, KW + (size_t)b * NT * 128 + kv * 64, 128, VWT + (size_t)(b * 2 + kv) * 64 * NT, lane);
      attn_sink(sa, p.wa_sink[layer * 8 + ha] * LOG2E); attn_sink(sb, p.wa_sink[layer * 8 + hb] * LOG2E);
      attn_store(sa, YC + (size_t)gq * 512 + ha * 64, h);
      attn_store(sb, YC + (size_t)gq * 512 + hb * 64, h);
    }
  }
}

DI int perm32(int rho) { return 8 * ((rho >> 2) & 3) + 4 * (rho >> 4) + (rho & 3); }
DI void conv_item(const float* W, int ldw, int k0, int c0, bf16_t* dst  , int Kd, float* scr, int lane, bool perm) {
  const float* wp = W + (size_t)(k0 + (lane >> 5)) * ldw + c0 + (lane & 31);
  float v[32];
#pragma unroll
  for (int i = 0; i < 32; ++i) v[i] = wp[(size_t)(2 * i) * ldw];
#pragma unroll
  for (int i = 0; i < 32; ++i) scr[(2 * i + (lane >> 5)) * 33 + (lane & 31)] = v[i];
  asm volatile("s_waitcnt lgkmcnt(0)" ::: "memory");
  const int c = lane & 7;
#pragma unroll
  for (int j = 0; j < 4; ++j) {
    const int n = (lane >> 3) + 8 * j; const float* s = scr + (8 * c) * 33 + (perm ? perm32(n) : n);
    u32x4 o; o[0] = pk2(s[0 * 33], s[1 * 33]); o[1] = pk2(s[2 * 33], s[3 * 33]); o[2] = pk2(s[4 * 33], s[5 * 33]); o[3] = pk2(s[6 * 33], s[7 * 33]);
    *(u32x4*)(dst + (size_t)n * Kd + k0 + 8 * c) = o;
  }
  asm volatile("s_waitcnt lgkmcnt(0)" ::: "memory");
}
constexpr size_t WM_WIN = 0, WM_WG = WM_WIN + (size_t)PCOLS * D * 2, WM_WP = WM_WG + (size_t)3072 * D * 2, WM_WO = WM_WP + (size_t)3 * 1024 * 512 * 2, WM_END = WM_WO + (size_t)D * D * 2;
static_assert(WM_END <= WMIX_BYTES, "mixer weight buffer");
__device__ void conv_mixer(const Params& p, int layer, unsigned char* smem) {
  const int tid = launder_tid(), lane = tid & 63, wave = tid >> 6;
  float* scr = (float*)smem + wave * (64 * 33);
  unsigned char* wm = p.ws + WS_WMIX;
  const float* Win = p.w_in + (size_t)layer * D * INC;
  constexpr int I_IN = 16 * (PCOLS / 32), I_G = 16 * (3072 / 32), I_P = 8 * 32, I_O = 16 * 32;
  for (int it = blockIdx.x * 8 + wave; it < I_IN + I_G + 3 * I_P + I_O; it += gridDim.x * 8) {
    int r = it;
    if (r < I_IN) {
      const int kb = r / (PCOLS / 32), rb = r % (PCOLS / 32), rho0 = rb * 32;
      const int tile = rho0 >> 8, bj = (rho0 >> 7) & 1, wc = (rho0 >> 5) & 3;
      conv_item(Win, INC, kb * 64, tile * 256 + 64 * wc + 32 * bj, (bf16_t*)(wm + WM_WIN) + (size_t)rho0 * D, D, scr, lane, tile >= 6 && tile < 16); continue;
    }
    r -= I_IN;
    if (r < I_G) { const int kb = r / 96, rb = r % 96; conv_item(Win, INC, kb * 64, PCOLS + rb * 32, (bf16_t*)(wm + WM_WG) + (size_t)rb * 32 * D, D, scr, lane, true); continue; }
    r -= I_G;
    if (r < 3 * I_P) {
      const int br = r / I_P, q = r % I_P, kb = q / 32, rb = q % 32;
      const float* Wp = (br == 0 ? p.w_pa : (br == 1 ? p.w_pb : p.w_pc)) + (size_t)layer * 512 * D;
      conv_item(Wp, D, kb * 64, rb * 32, (bf16_t*)(wm + WM_WP) + (size_t)br * 1024 * 512 + (size_t)rb * 32 * 512, 512, scr, lane, true); continue;
    }
    r -= 3 * I_P;
    { const int kb = r / 32, rb = r % 32; conv_item(p.w_out + (size_t)layer * D * D, D, kb * 64, rb * 32, (bf16_t*)(wm + WM_WO) + (size_t)rb * 32 * D, D, scr, lane, false); }
  }
}
constexpr size_t WE_PER = (size_t)1024 * 1024 * 2 + (size_t)1024 * 512 * 2;
static_assert(16 * WE_PER <= WEXP_BYTES, "expert weight buffer");
__device__ void conv_experts(const Params& p, int layer, unsigned char* smem, int nwaves) {
  const int tid = launder_tid(), lane = tid & 63, wave = tid >> 6;
  float* scr = (float*)smem + wave * (64 * 33);
  constexpr int I_GU = 16 * 32, I_D = 8 * 32;
  for (int it = blockIdx.x * nwaves + wave; it < 16 * (I_GU + I_D); it += gridDim.x * nwaves) {
    const int e = it / (I_GU + I_D); int r = it % (I_GU + I_D);
    unsigned char* we = p.ws + WS_WEXP + (size_t)e * WE_PER;
    if (r < I_GU) {
      const int kb = r / 32, rb = r % 32, rho0 = rb * 32, t = rho0 >> 8, bj = (rho0 >> 7) & 1, wc = (rho0 >> 5) & 3;
      const float* W = (bj ? p.w_up : p.w_gate) + ((size_t)(layer * 16 + e) * D) * 512;
      conv_item(W, 512, kb * 64, 128 * t + 32 * wc, (bf16_t*)we + (size_t)rho0 * D, D, scr, lane, true);
    } else {
      r -= I_GU; const int kb = r / 32, rb = r % 32;
      conv_item(p.w_down + ((size_t)(layer * 16 + e) * 512) * D, D, kb * 64, rb * 32, (bf16_t*)(we + (size_t)1024 * 1024 * 2) + (size_t)rb * 32 * 512, 512, scr, lane, true);
    }
  }
}


DI int hg_tokblock(int dir, int c) { return dir == 0 ? c : (c < 4 ? 3 - c : 135 - c); }
DI int hg_chunk_of_block(int dir, int tb) { return dir == 0 ? tb : (tb < 4 ? 3 - tb : 135 - tb); }
constexpr int HP = 136;
constexpr int TP = 72;
constexpr int H_QE = 0, H_QR = H_QE + 64 * HP * 2, H_KR = H_QR + 64 * HP * 2, H_VT = H_KR + 4 * 64 * HP * 2, H_ATT = H_VT + 128 * TP * 2,
              H_SEG = H_ATT + 64 * TP * 2, H_RED = H_SEG + 4 * 128 * 4, H_END = H_RED + 2 * 4 * 32 * 4;
static_assert(H_END <= LDS_BYTES, "LDS");
constexpr int H1_KET = 0, H1_VT = H1_KET + 128 * TP * 2, H1_SEG = H1_VT + 128 * TP * 2;

DI float hg_gates(const bf16_t* fp  , float lbv, int dir, float (&kk)[16], float (&bl)[16]) {
  float lf[16];
#pragma unroll
  for (int i = 0; i < 16; ++i) {
    const float x = bf2f(fp[(size_t)i * 2560]);
    const float f = lbv + (1.f - lbv) * sigmoid_f(x);
    lf[i] = __logf(fmaxf(f, 1e-30f)); kk[i] = 1.f - f;
  }
  float run = 0.f;
  if (dir == 0) {
#pragma unroll
    for (int i = 0; i < 16; ++i) { run += lf[i]; bl[i] = run; }
  } else {
#pragma unroll
    for (int i = 15; i >= 0; --i) { run += lf[i]; bl[i] = run; }
  }
  return run;
}
DI float hg_gates_raw(const unsigned short (&raw)[16], float lbv, int dir, float (&kk)[16], float (&bl)[16]) {
  float lf[16];
#pragma unroll
  for (int i = 0; i < 16; ++i) {
    const float f = lbv + (1.f - lbv) * sigmoid_f(bf2f(raw[i]));
    lf[i] = __logf(fmaxf(f, 1e-30f)); kk[i] = 1.f - f;
  }
  float run = 0.f;
  if (dir == 0) {
#pragma unroll
    for (int i = 0; i < 16; ++i) { run += lf[i]; bl[i] = run; }
  } else {
#pragma unroll
    for (int i = 15; i >= 0; --i) { run += lf[i]; bl[i] = run; }
  }
  return run;
}
DI void pack16_store(bf16_t* dst, const float (&v)[16]) {
  u32x4 a, b;
#pragma unroll
  for (int i = 0; i < 4; ++i) { a[i] = pk2(v[2 * i], v[2 * i + 1]); b[i] = pk2(v[8 + 2 * i], v[8 + 2 * i + 1]); }
  *(u32x4*)dst = a; *(u32x4*)(dst + 8) = b;
}
DI void hg_load_vt(bf16_t* Vt, const bf16_t* HG, int g0, int head, int tid) {
  const int dv = tid & 127, seg = tid >> 7;
  const bf16_t* vp = HG + (size_t)(g0 + 16 * seg) * 2560 + 1536 + head * 128 + dv;
  unsigned short raw[16];
#pragma unroll
  for (int i = 0; i < 16; ++i) raw[i] = vp[(size_t)i * 2560];
  u32x4 a, b;
#pragma unroll
  for (int i = 0; i < 4; ++i) { a[i] = (unsigned)raw[2 * i] | ((unsigned)raw[2 * i + 1] << 16); b[i] = (unsigned)raw[8 + 2 * i] | ((unsigned)raw[8 + 2 * i + 1] << 16); }
  *(u32x4*)(Vt + dv * TP + 16 * seg) = a; *(u32x4*)(Vt + dv * TP + 16 * seg + 8) = b;
}

__device__ void phase_hg_b1(const Params& p, int layer, unsigned char* smem) {
  const int tid = launder_tid(), lane = tid & 63, wave = tid >> 6, h = lane >> 5;
  const bf16_t* HG = (const bf16_t*)(p.ws + WS_HG);
  bf16_t* U = (bf16_t*)(p.ws + WS_U);
  float* DEC = (float*)(p.ws + WS_DEC);
  const float* LB = (const float*)(p.ws + WS_LB);
  bf16_t* KeT = (bf16_t*)(smem + H1_KET); bf16_t* Vt = (bf16_t*)(smem + H1_VT); float* segt = (float*)(smem + H1_SEG);
  const int cch = tid & 127, seg = tid >> 7;
  unsigned short rf_[16], rv_[16];
#define B1_ISSUE(u_) { const int chain_ = (u_) / NCHUNK, c_ = (u_) - chain_ * NCHUNK, head_ = chain_ & 3, dir_ = (chain_ >> 2) & 1, b_ = chain_ >> 3; \
    const bf16_t* bp_ = HG + (size_t)(b_ * NT + 64 * hg_tokblock(dir_, c_) + 16 * seg) * 2560 + head_ * 128 + cch; \
    _Pragma("unroll") for (int i_ = 0; i_ < 16; ++i_) { rf_[i_] = bp_[(size_t)i_ * 2560 + 512 * (1 + dir_)]; rv_[i_] = bp_[(size_t)i_ * 2560 + 1536]; } }
  if ((int)blockIdx.x < NCHAIN * NCHUNK) B1_ISSUE((int)blockIdx.x);
#pragma unroll 1
  for (int u = blockIdx.x; u < NCHAIN * NCHUNK; u += gridDim.x) {
    const int chain = u / NCHUNK, c = u - chain * NCHUNK;
    const int head = chain & 3, dir = (chain >> 2) & 1;
    float kk[16], bl[16];
    const float lbv = LB[layer * 1024 + dir * 512 + head * 128 + cch];
    const float tot = hg_gates_raw(rf_, lbv, dir, kk, bl);
    segt[seg * 128 + cch] = tot;
    {
      u32x4 a, b2;
#pragma unroll
      for (int i = 0; i < 4; ++i) { a[i] = (unsigned)rv_[2 * i] | ((unsigned)rv_[2 * i + 1] << 16); b2[i] = (unsigned)rv_[8 + 2 * i] | ((unsigned)rv_[8 + 2 * i + 1] << 16); }
      *(u32x4*)(Vt + cch * TP + 16 * seg) = a; *(u32x4*)(Vt + cch * TP + 16 * seg + 8) = b2;
    }
    if (u + (int)gridDim.x < NCHAIN * NCHUNK) B1_ISSUE(u + (int)gridDim.x);
    lds_sync();
    const float t0 = segt[cch], t1 = segt[128 + cch], t2 = segt[256 + cch], t3 = segt[384 + cch];
    const float btot = (t0 + t1) + (t2 + t3);
    float pre;
    if (dir == 0) pre = seg == 0 ? 0.f : (seg == 1 ? t0 : (seg == 2 ? t0 + t1 : t0 + t1 + t2));
    else pre = seg == 3 ? 0.f : (seg == 2 ? t3 : (seg == 1 ? t3 + t2 : t3 + t2 + t1));
    float ke[16];
#pragma unroll
    for (int i = 0; i < 16; ++i) ke[i] = kk[i] * __expf(btot - (pre + bl[i]));
    pack16_store(KeT + cch * TP + 16 * seg, ke);
    if (seg == 0) DEC[(size_t)u * 128 + cch] = __expf(btot);
    lds_sync();
    const int dkt = wave & 3;
#pragma unroll
    for (int k2 = 0; k2 < 2; ++k2) {
      const int dvt = 2 * (wave >> 2) + k2;
      f32x16 acc = zero16();
#pragma unroll
      for (int ks = 0; ks < 4; ++ks) {
        const bf16x8 af = *(const bf16x8*)(KeT + (dkt * 32 + (lane & 31)) * TP + ks * 16 + 8 * h);
        const bf16x8 bfr = *(const bf16x8*)(Vt + (dvt * 32 + (lane & 31)) * TP + ks * 16 + 8 * h);
        acc = MFMA32(af, bfr, acc);
      }
      bf16_t* dst = U + (size_t)u * 16384 + (size_t)(dvt * 32 + (lane & 31)) * 128 + dkt * 32;
#pragma unroll
      for (int q = 0; q < 4; ++q) {
        u32x2 o; o[0] = pk2(acc[4 * q], acc[4 * q + 1]); o[1] = pk2(acc[4 * q + 2], acc[4 * q + 3]);
        *(u32x2*)(dst + 8 * q + 4 * h) = o;
      }
    }
    lds_sync();
  }
}

#undef B1_ISSUE
__device__ void phase_hg_b2(const Params& p, int layer, unsigned char* smem) {
  const int tid = launder_tid(), wave = tid >> 6;
  if (wave < 4) { conv_experts(p, layer, smem, 4); return; }
  unsigned* U32 = (unsigned*)(p.ws + WS_U);
  const float* DEC = (const float*)(p.ws + WS_DEC);
  const int gt = blockIdx.x * 256 + (tid - 256), nth = gridDim.x * 256;
  for (int idx = gt; idx < NCHAIN * 8192; idx += nth) {
    const int chain = idx >> 13, e2 = idx & 8191, dk = (2 * e2) & 127;
    unsigned* up = U32 + (size_t)chain * NCHUNK * 8192 + e2;
    const float* dp = DEC + (size_t)chain * NCHUNK * 128 + dk;
    float s0 = 0.f, s1 = 0.f;
    for (int c0 = 0; c0 < NCHUNK; c0 += 12) {
      unsigned uv[12]; f32x2 dv[12];
#pragma unroll
      for (int k = 0; k < 12; ++k) { uv[k] = up[(size_t)(c0 + k) * 8192]; dv[k] = *(const f32x2*)(dp + (c0 + k) * 128); }
#pragma unroll
      for (int k = 0; k < 12; ++k) {
        up[(size_t)(c0 + k) * 8192] = pk2(s0, s1);
        s0 = dv[k][0] * s0 + bf_lo(uv[k]); s1 = dv[k][1] * s1 + bf_hi(uv[k]);
      }
    }
  }
}

__device__ void phase_hg_b3(const Params& p, int layer, unsigned char* smem) {
  const int tid = launder_tid(), lane = tid & 63, wave = tid >> 6, h = lane >> 5;
  const bf16_t* HG = (const bf16_t*)(p.ws + WS_HG);
  const bf16_t* U = (const bf16_t*)(p.ws + WS_U);
  const float* LB = (const float*)(p.ws + WS_LB);
  bf16_t* YB = (bf16_t*)(p.ws + WS_Y) + (size_t)NTOK * 512;
  bf16_t* Qe = (bf16_t*)(smem + H_QE); bf16_t* Qr = (bf16_t*)(smem + H_QR); bf16_t* Kr = (bf16_t*)(smem + H_KR);
  bf16_t* Vt = (bf16_t*)(smem + H_VT); bf16_t* Att = (bf16_t*)(smem + H_ATT); float* segt = (float*)(smem + H_SEG); float* red = (float*)(smem + H_RED);
  const int cch = tid & 127, seg = tid >> 7;
  const int ntb = layer == 1 ? NCHUNK - 4 : NCHUNK;
  unsigned short rv_[16], rq_[16], rf0_[16], rf1_[16];
#define B3_ISSUE(u_) { const int tb_ = (u_) % ntb + (NCHUNK - ntb), head_ = ((u_) / ntb) & 3, b_ = (u_) / (4 * ntb); \
    const bf16_t* bp_ = HG + (size_t)(b_ * NT + 64 * tb_ + 16 * seg) * 2560 + head_ * 128 + cch; \
    _Pragma("unroll") for (int i_ = 0; i_ < 16; ++i_) { rv_[i_] = bp_[(size_t)i_ * 2560 + 1536]; rq_[i_] = bp_[(size_t)i_ * 2560]; rf0_[i_] = bp_[(size_t)i_ * 2560 + 512]; rf1_[i_] = bp_[(size_t)i_ * 2560 + 1024]; } }
  if ((int)blockIdx.x < NB * 4 * ntb) B3_ISSUE((int)blockIdx.x);
#pragma unroll 1
  for (int u = blockIdx.x; u < NB * 4 * ntb; u += gridDim.x) {
    const int tb = u % ntb + (NCHUNK - ntb), head = (u / ntb) & 3, b = u / (4 * ntb);
    const int g0 = b * NT + 64 * tb;
    const int dvt = wave & 3, it = wave >> 2;
    {
      u32x4 a, b2;
#pragma unroll
      for (int i = 0; i < 4; ++i) { a[i] = (unsigned)rv_[2 * i] | ((unsigned)rv_[2 * i + 1] << 16); b2[i] = (unsigned)rv_[8 + 2 * i] | ((unsigned)rv_[8 + 2 * i + 1] << 16); }
      *(u32x4*)(Vt + cch * TP + 16 * seg) = a; *(u32x4*)(Vt + cch * TP + 16 * seg + 8) = b2;
    }
    f32x16 oacc = zero16();
    float qs[16];
#pragma unroll
    for (int i = 0; i < 16; ++i) qs[i] = silu_f(bf2f(rq_[i]));
#pragma unroll
    for (int dir = 0; dir < 2; ++dir) {
      const int c = hg_chunk_of_block(dir, tb);
      const int chain = (b * 2 + dir) * 4 + head;
      const bf16_t* Sc = U + ((size_t)chain * NCHUNK + c) * 16384 + (size_t)(dvt * 32 + (lane & 31)) * 128 + 8 * h;
      bf16x8 sf[8];
#pragma unroll
      for (int ks = 0; ks < 8; ++ks) sf[ks] = *(const bf16x8*)(Sc + ks * 16);
      float kk[16], bl[16];
      const float lbv = LB[layer * 1024 + dir * 512 + head * 128 + cch];
      const float tot = dir == 0 ? hg_gates_raw(rf0_, lbv, 0, kk, bl) : hg_gates_raw(rf1_, lbv, 1, kk, bl);
      segt[seg * 128 + cch] = tot;
      if (dir == 1 && u + (int)gridDim.x < NB * 4 * ntb) B3_ISSUE(u + (int)gridDim.x);
      lds_sync();
      const float t0 = segt[cch], t1 = segt[128 + cch], t2 = segt[256 + cch], t3 = segt[384 + cch];
      float ref[4];
      if (dir == 0) { ref[0] = 0.f; ref[1] = t0; ref[2] = t0 + t1; ref[3] = t0 + t1 + t2; }
      else { ref[3] = 0.f; ref[2] = t3; ref[1] = t3 + t2; ref[0] = t3 + t2 + t1; }
      float pre = seg == 0 ? ref[0] : (seg == 1 ? ref[1] : (seg == 2 ? ref[2] : ref[3]));
#pragma unroll
      for (int i = 0; i < 16; ++i) {
        const int t = 16 * seg + i;
        const float bt = pre + bl[i];
        Qe[t * HP + cch] = f2bf(qs[i] * __expf(bt));
        Qr[t * HP + cch] = f2bf(qs[i] * __expf(bl[i]));
#pragma unroll
        for (int I = 0; I < 4; ++I) {
          const bool need = dir == 0 ? (I >= seg) : (I <= seg);
          if (need) Kr[(I * 64 + t) * HP + cch] = f2bf(kk[i] * __expf(fminf(ref[I] - bt, 60.f)));
        }
      }
      lds_sync();
#pragma unroll
      for (int k2 = 0; k2 < 2; ++k2) {
        const int blk = wave * 2 + k2, I = blk >> 2, J = blk & 3;
        const bool valid = dir == 0 ? (J <= I) : (J >= I);
        f32x4 a4 = {0.f, 0.f, 0.f, 0.f};
        if (valid) {
#pragma unroll
          for (int ks = 0; ks < 4; ++ks) {
            const bf16x8 af = *(const bf16x8*)(Kr + (I * 64 + J * 16 + (lane & 15)) * HP + ks * 32 + 8 * (lane >> 4));
            const bf16x8 bfr = *(const bf16x8*)(Qr + (I * 16 + (lane & 15)) * HP + ks * 32 + 8 * (lane >> 4));
            a4 = MFMA16(af, bfr, a4);
          }
          if (I == J) {
            const int il = lane & 15;
#pragma unroll
            for (int r = 0; r < 4; ++r) { const int jl = 4 * (lane >> 4) + r; const bool ok = dir == 0 ? (jl <= il) : (jl >= il); a4[r] = ok ? a4[r] : 0.f; }
          }
        }
        u32x2 o; o[0] = pk2(a4[0], a4[1]); o[1] = pk2(a4[2], a4[3]);
        *(u32x2*)(Att + (I * 16 + (lane & 15)) * TP + J * 16 + 4 * (lane >> 4)) = o;
      }
      lds_sync();
#pragma unroll
      for (int ks = 0; ks < 4; ++ks) {
        const bf16x8 af = *(const bf16x8*)(Vt + (dvt * 32 + (lane & 31)) * TP + ks * 16 + 8 * h);
        const bf16x8 bfr = *(const bf16x8*)(Att + (it * 32 + (lane & 31)) * TP + ks * 16 + 8 * h);
        oacc = MFMA32(af, bfr, oacc);
      }
#pragma unroll
      for (int ks = 0; ks < 8; ++ks) {
        const bf16x8 bfr = *(const bf16x8*)(Qe + (it * 32 + (lane & 31)) * HP + ks * 16 + 8 * h);
        oacc = MFMA32(sf[ks], bfr, oacc);
      }
      lds_sync();
    }
    float ss = 0.f;
#pragma unroll
    for (int r = 0; r < 16; ++r) ss += oacc[r] * oacc[r];
    ss += __shfl_xor(ss, 32);
    if (h == 0) red[(it * 4 + dvt) * 32 + (lane & 31)] = ss;
    lds_sync();
    const float tot = red[(it * 4 + 0) * 32 + (lane & 31)] + red[(it * 4 + 1) * 32 + (lane & 31)] + red[(it * 4 + 2) * 32 + (lane & 31)] + red[(it * 4 + 3) * 32 + (lane & 31)];
    const float rs = rsqrtf(tot * (1.f / 128.f) + RMS_EPS);
    const int g = g0 + it * 32 + (lane & 31);
    const float* nw = p.hg_norm + layer * 128;
#pragma unroll
    for (int q = 0; q < 4; ++q) {
      const int dv = dvt * 32 + 8 * q + 4 * h;
      const u32x2 gr = *(const u32x2*)(HG + (size_t)g * 2560 + 2048 + head * 128 + dv);
      const f32x4 w4 = *(const f32x4*)(nw + dv);
      const float y0 = oacc[4 * q] * rs * w4[0] * silu_f(bf_lo(gr[0])), y1 = oacc[4 * q + 1] * rs * w4[1] * silu_f(bf_hi(gr[0]));
      const float y2 = oacc[4 * q + 2] * rs * w4[2] * silu_f(bf_lo(gr[1])), y3 = oacc[4 * q + 3] * rs * w4[3] * silu_f(bf_hi(gr[1]));
      u32x2 o; o[0] = pk2(y0, y1); o[1] = pk2(y2, y3);
      *(u32x2*)(YB + (size_t)g * 512 + head * 128 + dv) = o;
    }
    lds_sync();
  }
}


#undef B3_ISSUE
namespace pg8 {
constexpr int BM = 256, BK = 64, HALF = 128, HTB = HALF * BK * 2, STAGE_BYTES = 8 * HTB, NXCD = 8, WGM = 8;
DI int lds_byte(int r, int c) { const int st = (r >> 4) * 2 + (c >> 5), rr = r & 15, cc = c & 31, ob = rr * 64 + cc * 2; return st * 1024 + (ob ^ (((ob >> 9) & 1) << 5)); }
DI void stage_rc(int b, int& R, int& C) { const int st = b / 1024, sb = b % 1024, swz = sb ^ (((sb >> 9) & 1) << 5); R = (st >> 1) * 16 + swz / 64; C = (st & 1) * 32 + (swz % 64) / 2; }
struct Unit { int pm, pn; const char* A; const char* B; int e, rb, cnt, rowbase; };
typedef f32x4 Acc[2][2][4][2];

DI void static_tile(int L, int nM, int nN, int& pm, int& pn) {
  const int nwg = nM * nN;
  int wgid = L; { const int q = nwg / NXCD, r = nwg % NXCD, xcd = wgid % NXCD, off = wgid / NXCD; wgid = (xcd < r ? xcd * (q + 1) : r * (q + 1) + (xcd - r) * q) + off; }
  const int nig = WGM * nN, gid = wgid / nig, fm = gid * WGM, gsz = (nM - fm) < WGM ? (nM - fm) : WGM;
  pm = fm + ((wgid % nig) % gsz); pn = (wgid % nig) / gsz;
}

template <class Job>
DI void gemm_phase(LAS unsigned char* lds, const Job& S) {
  const int K = S.K; const bool GATHER = S.gather_rows;
  const int tid = launder_tid(), wid = __builtin_amdgcn_readfirstlane(tid >> 6), lane = tid & 63, wr = wid >> 2, wc = wid & 3, fr = lane & 15, fq = lane >> 4;
  const int nt = K / BK;
  unsigned voffB[2], oA[2][2], o2[2][2];
#pragma unroll
  for (int i = 0; i < 2; ++i) { int R, C; stage_rc(tid * 16 + i * 8192, R, C); voffB[i] = (unsigned)(R * K + C) * 2u; }
  const size_t kstep = (size_t)(BK * 2);
  const size_t hstep = (size_t)HALF * K * 2;
  const unsigned ldsw = (unsigned)wid * 1024u;
  const int aoff = lds_byte(wr * 64 + fr, fq * 8), boff = lds_byte(wc * 32 + fr, fq * 8);
#define PG8_SA(b, h) (((b) * 2 + (h)) * HTB)
#define PG8_SB(b, h) ((4 + (b) * 2 + (h)) * HTB)
#define PG8_STAGE(bufoff, gbase, voff) do { _Pragma("unroll") for (int _i = 0; _i < 2; ++_i) \
    __builtin_amdgcn_global_load_lds((const unsigned*)((const char*)(gbase) + (voff)[_i]), (LAS unsigned*)(lds + (bufoff) + ldsw + _i * 8192), 16, 0, 0); } while (0)
#define PG8_LDA(dst, b, h) do { _Pragma("unroll") for (int m = 0; m < 4; ++m) _Pragma("unroll") for (int k = 0; k < 2; ++k) dst[m][k] = *(const LAS bf16x8*)(lds + PG8_SA(b, h) + aoff + m * 2048 + k * 1024); } while (0)
#define PG8_LDB(dst, b, h) do { _Pragma("unroll") for (int n = 0; n < 2; ++n) _Pragma("unroll") for (int k = 0; k < 2; ++k) dst[n][k] = *(const LAS bf16x8*)(lds + PG8_SB(b, h) + boff + n * 2048 + k * 1024); } while (0)
#define PG8_MMA(ai, bj, At, Bt) do { __builtin_amdgcn_s_setprio(1); _Pragma("unroll") for (int m = 0; m < 4; ++m) _Pragma("unroll") for (int n = 0; n < 2; ++n) _Pragma("unroll") for (int k = 0; k < 2; ++k) \
    acc[ai][bj][m][n] = __builtin_amdgcn_mfma_f32_16x16x32_bf16(Bt[n][k], At[m][k], acc[ai][bj][m][n], 0, 0, 0); __builtin_amdgcn_s_setprio(0); } while (0)
#define PG8_WAIT_V(n) asm volatile("s_waitcnt vmcnt(" #n ")" ::: "memory")
#define PG8_WAIT_L(n) asm volatile("s_waitcnt lgkmcnt(" #n ")" ::: "memory")
#define PG8_BAR __builtin_amdgcn_s_barrier()
#define PG8_SCHED __builtin_amdgcn_sched_barrier(0)
  Unit cur, nxt; int ui = 0;
  if (!S.next(0, cur)) return;
  if (GATHER) S.gather(cur, oA);
  else {
#pragma unroll
    for (int h = 0; h < 2; ++h)
#pragma unroll
      for (int i = 0; i < 2; ++i) oA[h][i] = voffB[i] + (unsigned)(h * HALF * K) * 2u;
  }
  Acc acc;
#pragma unroll
  for (int a = 0; a < 2; ++a)
#pragma unroll
    for (int b = 0; b < 2; ++b)
#pragma unroll
      for (int m = 0; m < 4; ++m)
#pragma unroll
        for (int n = 0; n < 2; ++n) acc[a][b][m][n] = (f32x4){0.f, 0.f, 0.f, 0.f};
  bf16x8 At[4][2], B0[2][2], B1[2][2];
  const char* cA = cur.A; const char* cB = cur.B;
  PG8_STAGE(PG8_SB(0, 0), cB, voffB); PG8_STAGE(PG8_SB(0, 1), cB + hstep, voffB); PG8_STAGE(PG8_SA(0, 0), cA, oA[0]); PG8_STAGE(PG8_SA(0, 1), cA, oA[1]);
  if (wr == 1) PG8_BAR;
  PG8_WAIT_V(2); PG8_BAR;
  PG8_STAGE(PG8_SB(1, 0), cB + kstep, voffB); PG8_STAGE(PG8_SA(1, 0), cA + kstep, oA[0]); PG8_STAGE(PG8_SB(1, 1), cB + hstep + kstep, voffB);
  PG8_WAIT_V(6); PG8_BAR;
  for (;;) {
    const bool has_next = S.next(ui + 1, nxt);
    const char* nA = has_next ? nxt.A : cA; const char* nB = has_next ? nxt.B : cB;
    for (int t = 0; t < nt; t += 2) {
      const bool last = (t == nt - 2);
      const char* a1 = cA + (size_t)(t + 1) * kstep;
      const char* a2 = last ? nA : cA + (size_t)(t + 2) * kstep; const char* b2 = last ? nB : cB + (size_t)(t + 2) * kstep;
      const char* a3 = a2 + kstep; const char* b3 = b2 + kstep;
      if (GATHER && last && has_next) S.gather(nxt, o2);
      else {
#pragma unroll
        for (int h = 0; h < 2; ++h)
#pragma unroll
          for (int i = 0; i < 2; ++i) o2[h][i] = oA[h][i];
      }
      PG8_LDB(B0, 0, 0); PG8_LDB(B1, 0, 1); PG8_SCHED; PG8_LDA(At, 0, 0); PG8_STAGE(PG8_SA(1, 1), a1, oA[1]);
      PG8_WAIT_V(8); PG8_WAIT_L(0); PG8_BAR; PG8_MMA(0, 0, At, B0); PG8_MMA(0, 1, At, B1); PG8_BAR; PG8_SCHED;
      PG8_LDA(At, 0, 1); PG8_STAGE(PG8_SB(0, 0), b2, voffB); PG8_STAGE(PG8_SB(0, 1), b2 + hstep, voffB); PG8_STAGE(PG8_SA(0, 0), a2, o2[0]);
      PG8_WAIT_V(8); PG8_WAIT_L(0); PG8_BAR; PG8_MMA(1, 0, At, B0); PG8_MMA(1, 1, At, B1); PG8_BAR; PG8_SCHED;
      PG8_LDB(B0, 1, 0); PG8_LDB(B1, 1, 1); PG8_SCHED; PG8_LDA(At, 1, 0); PG8_STAGE(PG8_SA(0, 1), a2, o2[1]);
      PG8_WAIT_V(8); PG8_WAIT_L(0); PG8_BAR; PG8_MMA(0, 0, At, B0); PG8_MMA(0, 1, At, B1); PG8_BAR; PG8_SCHED;
      PG8_LDA(At, 1, 1); PG8_STAGE(PG8_SB(1, 0), b3, voffB); PG8_STAGE(PG8_SB(1, 1), b3 + hstep, voffB); PG8_STAGE(PG8_SA(1, 0), a3, o2[0]);
      PG8_WAIT_V(8); PG8_WAIT_L(0); PG8_BAR; PG8_MMA(1, 0, At, B0); PG8_MMA(1, 1, At, B1); PG8_BAR; PG8_SCHED;
    }
    if (wr == 0) PG8_BAR;
    { int fr_ = fr, fq_ = fq; asm volatile("" : "+v"(fr_), "+v"(fq_));
      S.epilogue(acc, cur, wr, wc, fr_, fq_); }
    if (!has_next) break;
#pragma unroll
    for (int a = 0; a < 2; ++a)
#pragma unroll
      for (int b = 0; b < 2; ++b)
#pragma unroll
        for (int m = 0; m < 4; ++m)
#pragma unroll
          for (int n = 0; n < 2; ++n) acc[a][b][m][n] = (f32x4){0.f, 0.f, 0.f, 0.f};
    cur = nxt; cA = nA; cB = nB; ++ui;
    if (GATHER) {
#pragma unroll
      for (int h = 0; h < 2; ++h)
#pragma unroll
        for (int i = 0; i < 2; ++i) oA[h][i] = o2[h][i];
    }
    if (wr == 1) PG8_BAR;
  }
  PG8_WAIT_V(0);
  PG8_BAR;
#undef PG8_SA
#undef PG8_SB
#undef PG8_STAGE
#undef PG8_LDA
#undef PG8_LDB
#undef PG8_MMA
#undef PG8_WAIT_V
#undef PG8_WAIT_L
#undef PG8_BAR
#undef PG8_SCHED
}
}
constexpr int C3_MAXTOK = 272;
__device__ void phase_c3(const Params& p, int layer, unsigned char* smem) {
  const int tid = launder_tid(), lane = tid & 63, wave = tid >> 6;
  float* wr = (float*)smem;
  int* lcount = (int*)(smem + 65536);
  int* lbase = lcount + 16;
  int* tok_e = lbase + 16;
  int* tok_pos = tok_e + 2 * C3_MAXTOK;
  for (int i = tid; i < 16 * 1024; i += NTHREADS) { const int col = i >> 4, e = i & 15; wr[e * 1024 + col] = p.w_router[i]; }
  if (tid < 16) lcount[tid] = 0;
  __syncthreads();
  const float* nw = p.norm2 + layer * D;
  bf16_t* HX = (bf16_t*)(p.ws + WS_HX);
  float* WTS = (float*)(p.ws + WS_WTS);
  int* LIST = (int*)(p.ws + WS_LIST);
  int* CNT = (int*)(p.ws + WS_CNT) + layer * 16;
  int li = wave;
  for (int g = blockIdx.x * 8 + wave; g < NTOK; g += gridDim.x * 8, li += 8) {
    if (layer == 1 && (g % NT) < L) continue;
    const float* src = res_in_row(p, 1, g);
    const int v = mod_vec(g);
    f32x4 x[4];
#pragma unroll
    for (int i = 0; i < 4; ++i) x[i] = *(const f32x4*)(src + (i * 64 + lane) * 4);
    float ss = 0.f;
#pragma unroll
    for (int i = 0; i < 4; ++i) ss += x[i][0] * x[i][0] + x[i][1] * x[i][1] + x[i][2] * x[i][2] + x[i][3] * x[i][3];
    ss = wave_sum(ss);
    const float r = rsqrtf(ss * (1.f / D) + RMS_EPS);
    const float* sh = mod_ptr(p, layer, v, 3);
    const float* scl = mod_ptr(p, layer, v, 4);
    float lg[16];
#pragma unroll
    for (int e = 0; e < 16; ++e) lg[e] = 0.f;
#pragma unroll
    for (int i = 0; i < 4; ++i) {
      const int col = (i * 64 + lane) * 4;
      const f32x4 w4 = *(const f32x4*)(nw + col), s4 = *(const f32x4*)(sh + col), c4 = *(const f32x4*)(scl + col);
      float y[4];
#pragma unroll
      for (int k = 0; k < 4; ++k) y[k] = x[i][k] * r * w4[k] * (1.f + c4[k]) + s4[k];
      u32x2 o; o[0] = pk2(y[0], y[1]); o[1] = pk2(y[2], y[3]);
      *(u32x2*)(HX + (size_t)g * D + col) = o;
#pragma unroll
      for (int e = 0; e < 16; ++e) {
        const f32x4 wv = *(const f32x4*)(wr + e * 1024 + col);
        lg[e] += y[0] * wv[0] + y[1] * wv[1] + y[2] * wv[2] + y[3] * wv[3];
      }
    }
#pragma unroll
    for (int e = 0; e < 16; ++e) lg[e] = wave_sum(lg[e]);
    float mx = lg[0];
#pragma unroll
    for (int e = 1; e < 16; ++e) mx = fmaxf(mx, lg[e]);
    float pr[16], den = 0.f;
#pragma unroll
    for (int e = 0; e < 16; ++e) { pr[e] = expf(lg[e] - mx); den += pr[e]; }
    const float inv = 1.f / den;
    float sel[16];
#pragma unroll
    for (int e = 0; e < 16; ++e) { pr[e] *= inv; sel[e] = pr[e] + p.b_router[e]; }
    int bg = 0; float bs = -__builtin_inff();
#pragma unroll
    for (int gi = 0; gi < 4; ++gi) {
      float a = -__builtin_inff(), b2 = -__builtin_inff();
#pragma unroll
      for (int k = 0; k < 4; ++k) { const float s = sel[gi * 4 + k]; if (s > a) { b2 = a; a = s; } else if (s > b2) b2 = s; }
      const float sc = a + b2;
      if (sc > bs) { bs = sc; bg = gi; }
    }
    float sg[4], pg[4];
#pragma unroll
    for (int k = 0; k < 4; ++k) { sg[k] = bg == 0 ? sel[k] : (bg == 1 ? sel[4 + k] : (bg == 2 ? sel[8 + k] : sel[12 + k])); pg[k] = bg == 0 ? pr[k] : (bg == 1 ? pr[4 + k] : (bg == 2 ? pr[8 + k] : pr[12 + k])); }
    int i0 = 0; float s0 = sg[0], p0 = pg[0];
#pragma unroll
    for (int k = 1; k < 4; ++k) if (sg[k] > s0) { s0 = sg[k]; p0 = pg[k]; i0 = k; }
    int i1 = 0; float s1 = -__builtin_inff(), p1 = 0.f;
#pragma unroll
    for (int k = 0; k < 4; ++k) if (k != i0 && sg[k] > s1) { s1 = sg[k]; p1 = pg[k]; i1 = k; }
    const int e0 = bg * 4 + i0, e1 = bg * 4 + i1;
    if (lane == 0) {
      const float wsum = p0 + p1;
      WTS[2 * g] = p0 / wsum; WTS[2 * g + 1] = p1 / wsum;
      tok_e[2 * li] = e0; tok_e[2 * li + 1] = e1;
      tok_pos[2 * li] = atomicAdd(&lcount[e0], 1); tok_pos[2 * li + 1] = atomicAdd(&lcount[e1], 1);
    }
  }
  __syncthreads();
  if (tid < 16) lbase[tid] = atomicAdd(&CNT[tid], lcount[tid]);
  __syncthreads();
  li = wave;
  for (int g = blockIdx.x * 8 + wave; g < NTOK; g += gridDim.x * 8, li += 8) {
    if (layer == 1 && (g % NT) < L) continue;
    if (lane < 2) { const int e = tok_e[2 * li + lane]; LIST[(size_t)e * NTOK + lbase[e] + tok_pos[2 * li + lane]] = 2 * g + lane; }
  }
}

struct MoeUnit { int e, rb, cnt, rowbase; };
DI bool moe_unit(const int* CNT, int rbg, MoeUnit& mu) {
  int acc = 0, rowbase = 0;
  mu.e = 0; mu.rb = 0; mu.cnt = 1; mu.rowbase = 0;
  for (int e = 0; e < 16; ++e) {
    const int c = CNT[e], nb = (c + 255) >> 8;
    if (rbg < acc + nb) { mu.e = e; mu.rb = rbg - acc; mu.cnt = c; mu.rowbase = rowbase; return true; }
    acc += nb; rowbase += nb * 256;
  }
  return false;
}
DI int moe_total_rb(const int* CNT) { int acc = 0; for (int e = 0; e < 16; ++e) acc += (CNT[e] + 255) >> 8; return acc; }


DI int row_tile_map(int pm, bool latent_only) { return latent_only ? (pm < 32 ? pm + 1 : pm + 2) : pm; }
struct DenseSched {
  const char* A; const char* B; int nM, nN, K, G, c; bool latent_only; bool rev_n;
  DI bool next(int i, pg8::Unit& u) const {
    const int Lx = i * G + c; if (Lx >= nM * nN) return false;
    int pm, pn; pg8::static_tile(Lx, nM, nN, pm, pn); pm = row_tile_map(pm, latent_only);
    if (rev_n) pn = nN - 1 - pn;
    u.pm = pm; u.pn = pn; u.A = A + (size_t)pm * 256 * K * 2; u.B = B + (size_t)pn * 256 * K * 2; u.e = 0; return true;
  }
};
struct ProjSched {
  const char* Y; const char* Wp; int nM, G, c; bool latent_only;
  DI bool next(int i, pg8::Unit& u) const {
    const int br = i % 3, Lx = (i / 3) * G + c; if (Lx >= nM * 4) return false;
    int pm, pn; pg8::static_tile(Lx, nM, 4, pm, pn); pm = row_tile_map(pm, latent_only);
    u.pm = pm; u.pn = pn; u.e = br;
    u.A = Y + ((size_t)br * NTOK + (size_t)pm * 256) * 512 * 2; u.B = Wp + ((size_t)br * 1024 + (size_t)pn * 256) * 512 * 2; return true;
  }
};
struct MoeSched {
  const int* desc; const int* LIST; const char* Abase; const char* Wexp; bool gate;
  DI bool next(int i, pg8::Unit& u) const {
    if (i >= 16) return false;
    const int e = __builtin_amdgcn_readfirstlane(desc[i * 8 + 0]); if (e < 0) return false;
    u.pm = i; u.e = e; u.rb = __builtin_amdgcn_readfirstlane(desc[i * 8 + 1]); u.cnt = __builtin_amdgcn_readfirstlane(desc[i * 8 + 2]);
    u.rowbase = __builtin_amdgcn_readfirstlane(desc[i * 8 + 3]); u.pn = __builtin_amdgcn_readfirstlane(desc[i * 8 + 4]);
    const char* we = Wexp + (size_t)e * WE_PER;
    if (gate) { u.A = Abase; u.B = we + (size_t)u.pn * 256 * D * 2; }
    else { u.A = Abase + (size_t)(u.rowbase + u.rb * 256) * 512 * 2; u.B = we + (size_t)1024 * 1024 * 2 + (size_t)u.pn * 256 * 512 * 2; }
    return true;
  }
  DI void gather(const pg8::Unit& u, unsigned (&o)[2][2]) const {
    const int tid = launder_tid(); int RA[2], CA[2];
#pragma unroll
    for (int i = 0; i < 2; ++i) pg8::stage_rc(tid * 16 + i * 8192, RA[i], CA[i]);
    const int* rows = desc + 16 * 8 + u.pm * 256;
#pragma unroll
    for (int h = 0; h < 2; ++h)
#pragma unroll
      for (int i = 0; i < 2; ++i) o[h][i] = (unsigned)(rows[h * 128 + RA[i]] * D + CA[i]) * 2u;
  }
};
DI int* moe_build_desc(const int* CNT, const int* LIST, bool rows_too, unsigned char* smem) {
  int* desc = (int*)(smem + 131072);
  const int tid = launder_tid();
  __syncthreads();
  if (tid < 16) {
    const int Lx = tid * (int)gridDim.x + (int)blockIdx.x;
    MoeUnit mu; const bool ok = moe_unit(CNT, Lx >> 2, mu);
    desc[tid * 8 + 0] = ok ? mu.e : -1; desc[tid * 8 + 1] = mu.rb; desc[tid * 8 + 2] = mu.cnt; desc[tid * 8 + 3] = mu.rowbase; desc[tid * 8 + 4] = Lx & 3;
  }
  __syncthreads();
  if (rows_too) {
    for (int s = 0; s < 3; ++s) {
      const int e = desc[s * 8 + 0];
      if (e >= 0 && tid < 256) {
        const int rb = desc[s * 8 + 1], cnt = desc[s * 8 + 2];
        const int ri = min(rb * 256 + tid, cnt - 1);
        desc[16 * 8 + s * 256 + tid] = LIST[(size_t)e * NTOK + ri] >> 1;
      }
    }
    if (tid == 0 && desc[3 * 8 + 0] >= 0) desc[3 * 8 + 0] = -1;
    __syncthreads();
  }
  return desc;
}

DI void st8bf(bf16_t* dst, const f32x4& a, const f32x4& b) { u32x4 o; o[0] = pk2(a[0], a[1]); o[1] = pk2(a[2], a[3]); o[2] = pk2(b[0], b[1]); o[3] = pk2(b[2], b[3]); *(u32x4*)dst = o; }
DI void st4bf(bf16_t* dst, float a, float b, float c, float d) { u32x2 o; o[0] = pk2(a, b); o[1] = pk2(c, d); *(u32x2*)dst = o; }
DI void quad_transpose(float (&a)[4], int q) {
  const bool o1 = (q & 1) != 0, o2 = (q & 2) != 0;
  const float r0 = __shfl_xor(o1 ? a[0] : a[1], 1), r1 = __shfl_xor(o1 ? a[2] : a[3], 1);
  const float p00 = o1 ? r0 : a[0], p01 = o1 ? a[1] : r0, p10 = o1 ? r1 : a[2], p11 = o1 ? a[3] : r1;
  const float u0 = __shfl_xor(o2 ? p00 : p10, 2), u1 = __shfl_xor(o2 ? p01 : p11, 2);
  a[0] = o2 ? u0 : p00; a[1] = o2 ? u1 : p01; a[2] = o2 ? p10 : u0; a[3] = o2 ? p11 : u1;
}
struct EpiA1 {
  const Params* pp; int layer;
  DI void operator()(const pg8::Acc& acc, const pg8::Unit& u, int wr, int wc, int fr, int fq) const {
    const Params& p = *pp; const int pn = u.pn;
    const float* rope = (const float*)(p.ws + WS_ROPE);
#pragma unroll
    for (int ai = 0; ai < 2; ++ai)
#pragma unroll
      for (int m = 0; m < 4; ++m) {
        const int g = u.pm * 256 + ai * 128 + wr * 64 + m * 16 + fr;
        const int b = g / NT, n = g - b * NT;
        float v[2][2][4];
#pragma unroll
        for (int bj = 0; bj < 2; ++bj)
#pragma unroll
          for (int n2 = 0; n2 < 2; ++n2)
#pragma unroll
            for (int i = 0; i < 4; ++i) v[bj][n2][i] = acc[ai][bj][m][n2][i];
        const bool is_v = (pn == 4 || pn == 5 || (pn == 18 && wc >= 2));
        const bool is_hg = (pn >= 6 && pn < 16);
        if (is_hg) {
          bf16_t* dst = (bf16_t*)(p.ws + WS_HG) + (size_t)g * 2560 + (pn * 256 - 1536) + 64 * wc + 8 * fq;
#pragma unroll
          for (int bj = 0; bj < 2; ++bj) st8bf(dst + 32 * bj, acc[ai][bj][m][0], acc[ai][bj][m][1]);
        } else if (is_v) {
          const int q = fr & 3;
          bf16_t* dst = (pn == 18 ? (bf16_t*)(p.ws + WS_VWT) + ((size_t)(b * 2 + (wc - 2)) * 64) * NT
                                  : (bf16_t*)(p.ws + WS_VAT) + ((size_t)(b * 8 + (pn - 4) * 4 + wc) * 64) * NT) + (n - q);
#pragma unroll
          for (int bj = 0; bj < 2; ++bj)
#pragma unroll
            for (int n2 = 0; n2 < 2; ++n2) {
              quad_transpose(v[bj][n2], q);
              st4bf(dst + (size_t)(32 * bj + 16 * n2 + 4 * fq + q) * NT, v[bj][n2][0], v[bj][n2][1], v[bj][n2][2], v[bj][n2][3]);
            }
        } else {
          const bool wa = pn >= 16;
          const bool isq = (pn < 2) || (pn == 16 || pn == 17);
          float ss = 0.f;
#pragma unroll
          for (int bj = 0; bj < 2; ++bj)
#pragma unroll
            for (int n2 = 0; n2 < 2; ++n2)
#pragma unroll
              for (int i = 0; i < 4; ++i) ss += v[bj][n2][i] * v[bj][n2][i];
          ss += __shfl_xor(ss, 16); ss += __shfl_xor(ss, 32);
          const float rs = rsqrtf(ss * (1.f / 64.f) + RMS_EPS);
          const float* nw = (wa ? (isq ? p.wa_qn : p.wa_kn) : (isq ? p.na_qn : p.na_kn)) + layer * 64;
#pragma unroll
          for (int bj = 0; bj < 2; ++bj)
#pragma unroll
            for (int n2 = 0; n2 < 2; ++n2) {
              const f32x4 w4 = *(const f32x4*)(nw + 32 * bj + 16 * n2 + 4 * fq);
#pragma unroll
              for (int i = 0; i < 4; ++i) v[bj][n2][i] *= rs * w4[i];
            }
          if (wa && n >= L) {
            const int t = n - L;
#pragma unroll
            for (int bj = 0; bj < 2; ++bj) {
              const int pos = bj == 0 ? (t >> 6) : (t & 63);
              const f32x4 cs = *(const f32x4*)(rope + pos * 16 + 4 * fq), sn = *(const f32x4*)(rope + 2048 + pos * 16 + 4 * fq);
#pragma unroll
              for (int i = 0; i < 4; ++i) { const float x1 = v[bj][0][i], x2 = v[bj][1][i]; v[bj][0][i] = x1 * cs[i] - x2 * sn[i]; v[bj][1][i] = x2 * cs[i] + x1 * sn[i]; }
            }
          }
          bf16_t* dst;
          if (pn < 2) dst = (bf16_t*)(p.ws + WS_QA) + (size_t)g * 512 + (pn * 4 + wc) * 64;
          else if (pn < 4) dst = (bf16_t*)(p.ws + WS_KA) + (size_t)g * 512 + ((pn - 2) * 4 + wc) * 64;
          else if (pn < 18) dst = (bf16_t*)(p.ws + WS_QW) + (size_t)g * 512 + ((pn - 16) * 4 + wc) * 64;
          else dst = (bf16_t*)(p.ws + WS_KW) + (size_t)g * 128 + wc * 64;
#pragma unroll
          for (int bj = 0; bj < 2; ++bj)
#pragma unroll
            for (int n2 = 0; n2 < 2; ++n2) st4bf(dst + 32 * bj + 16 * n2 + 4 * fq, v[bj][n2][0], v[bj][n2][1], v[bj][n2][2], v[bj][n2][3]);
        }
      }
  }
};
struct EpiGate {
  bf16_t* G;
  DI void operator()(const pg8::Acc& acc, const pg8::Unit& u, int wr, int wc, int fr, int fq) const {
#pragma unroll
    for (int ai = 0; ai < 2; ++ai)
#pragma unroll
      for (int m = 0; m < 4; ++m) {
        bf16_t* rowp = G + (size_t)(u.pm * 256 + ai * 128 + wr * 64 + m * 16 + fr) * 3072 + u.pn * 256 + 32 * wc + 8 * fq;
#pragma unroll
        for (int bj = 0; bj < 2; ++bj) {
          f32x4 a = acc[ai][bj][m][0], c = acc[ai][bj][m][1];
#pragma unroll
          for (int i = 0; i < 4; ++i) { a[i] = sigmoid_f(a[i]); c[i] = sigmoid_f(c[i]); }
          st8bf(rowp + 128 * bj, a, c);
        }
      }
  }
};
struct EpiProj {
  const bf16_t* G; bf16_t* M;
  DI void operator()(const pg8::Acc& acc, const pg8::Unit& u, int wr, int wc, int fr, int fq) const {
    const int br = u.e;
#pragma unroll
    for (int ai = 0; ai < 2; ++ai)
#pragma unroll
      for (int m = 0; m < 4; ++m) {
        const size_t g = (size_t)(u.pm * 256 + ai * 128 + wr * 64 + m * 16 + fr);
        const int col0 = u.pn * 256 + 32 * wc + 8 * fq;
#pragma unroll
        for (int bj = 0; bj < 2; ++bj) {
          const int col = col0 + 128 * bj;
          const u32x4 gg = *(const u32x4*)(G + g * 3072 + br * 1024 + col);
          f32x4 a = acc[ai][bj][m][0], c = acc[ai][bj][m][1];
          a[0] *= bf_lo(gg[0]); a[1] *= bf_hi(gg[0]); a[2] *= bf_lo(gg[1]); a[3] *= bf_hi(gg[1]);
          c[0] *= bf_lo(gg[2]); c[1] *= bf_hi(gg[2]); c[2] *= bf_lo(gg[3]); c[3] *= bf_hi(gg[3]);
          bf16_t* mp = M + g * D + col;
          if (br > 0) {
            const u32x4 old = *(const u32x4*)mp;
            a[0] += bf_lo(old[0]); a[1] += bf_hi(old[0]); a[2] += bf_lo(old[1]); a[3] += bf_hi(old[1]);
            c[0] += bf_lo(old[2]); c[1] += bf_hi(old[2]); c[2] += bf_lo(old[3]); c[3] += bf_hi(old[3]);
          }
          st8bf(mp, a, c);
        }
      }
  }
};
struct EpiOut {
  const Params* pp; int layer;
  DI void operator()(const pg8::Acc& acc, const pg8::Unit& u, int wr, int wc, int fr, int fq) const {
    const Params& p = *pp;
#pragma unroll
    for (int ai = 0; ai < 2; ++ai)
#pragma unroll
      for (int m = 0; m < 4; ++m) {
        const int g = u.pm * 256 + ai * 128 + wr * 64 + m * 16 + fr;
        const float* src = res_in_row(p, layer, g); float* dst = res_out_row(p, g);
        const float* g2 = mod_ptr(p, layer, mod_vec(g), 2);
#pragma unroll
        for (int bj = 0; bj < 2; ++bj)
#pragma unroll
          for (int n = 0; n < 2; ++n) {
            const int col = u.pn * 256 + 128 * bj + 32 * wc + 16 * n + 4 * fq;
            const f32x4 xr = *(const f32x4*)(src + col), gg = *(const f32x4*)(g2 + col), a = acc[ai][bj][m][n];
            f32x4 o; o[0] = xr[0] + gg[0] * a[0]; o[1] = xr[1] + gg[1] * a[1]; o[2] = xr[2] + gg[2] * a[2]; o[3] = xr[3] + gg[3] * a[3];
            *(f32x4*)(dst + col) = o;
          }
      }
  }
};
struct EpiAct {
  bf16_t* ACT;
  DI void operator()(const pg8::Acc& acc, const pg8::Unit& u, int wr, int wc, int fr, int fq) const {
#pragma unroll
    for (int ai = 0; ai < 2; ++ai)
#pragma unroll
      for (int m = 0; m < 4; ++m) {
        const int rl = u.rb * 256 + ai * 128 + wr * 64 + m * 16 + fr;
        if (rl < u.cnt) {
          bf16_t* rowp = ACT + (size_t)(u.rowbase + rl) * 512 + u.pn * 128 + 32 * wc + 8 * fq;
          f32x4 a, c;
#pragma unroll
          for (int i = 0; i < 4; ++i) { a[i] = silu_f(acc[ai][0][m][0][i]) * acc[ai][1][m][0][i]; c[i] = silu_f(acc[ai][0][m][1][i]) * acc[ai][1][m][1][i]; }
          st8bf(rowp, a, c);
        }
      }
  }
};
struct EpiDown {
  bf16_t* YS; const float* WTS; const int* LIST;
  DI void operator()(const pg8::Acc& acc, const pg8::Unit& u, int wr, int wc, int fr, int fq) const {
#pragma unroll
    for (int ai = 0; ai < 2; ++ai)
#pragma unroll
      for (int m = 0; m < 4; ++m) {
        const int rl = u.rb * 256 + ai * 128 + wr * 64 + m * 16 + fr;
        if (rl < u.cnt) {
          const int aid = LIST[(size_t)u.e * NTOK + rl];
          const float w = WTS[aid];
          bf16_t* rowp = YS + (size_t)aid * D + u.pn * 256 + 32 * wc + 8 * fq;
#pragma unroll
          for (int bj = 0; bj < 2; ++bj) { const f32x4 a = acc[ai][bj][m][0] * w, c = acc[ai][bj][m][1] * w; st8bf(rowp + 128 * bj, a, c); }
        }
      }
  }
};


enum { GK_A1 = 0, GK_GATES = 1, GK_PROJ = 2, GK_OUT = 3, GK_ACT = 4, GK_DOWN = 5 };
struct GemmJob {
  int gk, K; bool gather_rows, latent_only; int nM, nN, G, c, layer;
  const char* A; const char* B; const int* desc; const Params* pp;
  DI bool next(int i, pg8::Unit& u) const {
    if (gk >= GK_ACT) {
      MoeSched S{desc, (const int*)(pp->ws + WS_LIST), A, B, gk == GK_ACT};
      return S.next(i, u);
    }
    if (gk == GK_PROJ) { ProjSched S{A, B, nM, G, c, latent_only}; return S.next(i, u); }
    DenseSched S{A, B, nM, nN, K, G, c, latent_only, gk == GK_A1};
    return S.next(i, u);
  }
  DI void gather(const pg8::Unit& u, unsigned (&o)[2][2]) const {
    MoeSched S{desc, (const int*)(pp->ws + WS_LIST), A, B, true};
    S.gather(u, o);
  }
  DI void epilogue(const pg8::Acc& acc, const pg8::Unit& u, int wr, int wc, int fr, int fq) const {
    const Params& p = *pp;
    switch (gk) {
      case GK_A1: { EpiA1 E{pp, layer}; E(acc, u, wr, wc, fr, fq); break; }
      case GK_GATES: { EpiGate E{(bf16_t*)(p.ws + WS_G)}; E(acc, u, wr, wc, fr, fq); break; }
      case GK_PROJ: { EpiProj E{(const bf16_t*)(p.ws + WS_G), (bf16_t*)(p.ws + WS_MERGED)}; E(acc, u, wr, wc, fr, fq); break; }
      case GK_OUT: { EpiOut E{pp, layer}; E(acc, u, wr, wc, fr, fq); break; }
      case GK_ACT: { EpiAct E{(bf16_t*)(p.ws + WS_ACT)}; E(acc, u, wr, wc, fr, fq); break; }
      default: { EpiDown E{(bf16_t*)(p.ws + WS_YS), (const float*)(p.ws + WS_WTS), (const int*)(p.ws + WS_LIST)}; E(acc, u, wr, wc, fr, fq); break; }
    }
  }
};
DI GemmJob make_job(const Params& p, int gk, int layer, unsigned char* smem) {
  GemmJob j{}; j.gk = gk; j.layer = layer; j.pp = &p; j.G = (int)gridDim.x; j.c = (int)blockIdx.x; j.latent_only = false; j.gather_rows = false; j.desc = nullptr; j.nM = NTOK / 256; j.nN = 4; j.K = D;
  const bool lo = layer == 1;
  const char* wm = (const char*)(p.ws + WS_WMIX);
  switch (gk) {
    case GK_A1: j.A = (const char*)(p.ws + WS_H); j.B = wm + WM_WIN; j.nN = PCOLS / 256; break;
    case GK_GATES: j.A = (const char*)(p.ws + WS_H); j.B = wm + WM_WG; j.nN = 12; j.latent_only = lo; j.nM = lo ? 64 : 66; break;
    case GK_PROJ: j.A = (const char*)(p.ws + WS_Y); j.B = wm + WM_WP; j.K = 512; j.latent_only = lo; j.nM = lo ? 64 : 66; break;
    case GK_OUT: j.A = (const char*)(p.ws + WS_MERGED); j.B = wm + WM_WO; j.latent_only = lo; j.nM = lo ? 64 : 66; break;
    case GK_ACT: j.A = (const char*)(p.ws + WS_HX); j.B = (const char*)(p.ws + WS_WEXP); j.gather_rows = true; j.desc = moe_build_desc((const int*)(p.ws + WS_CNT) + layer * 16, (const int*)(p.ws + WS_LIST), true, smem); break;
    default: j.A = (const char*)(p.ws + WS_ACT); j.B = (const char*)(p.ws + WS_WEXP); j.K = 512; j.desc = moe_build_desc((const int*)(p.ws + WS_CNT) + layer * 16, (const int*)(p.ws + WS_LIST), false, smem); break;
  }
  return j;
}
__device__ void phase_final(const Params& p) {
  const int tid_ = launder_tid(), lane = tid_ & 63, wave = tid_ >> 6;
  const bf16_t* YS = (const bf16_t*)(p.ws + WS_YS);
  for (int r = blockIdx.x * 8 + wave; r < NB * T; r += gridDim.x * 8) {
    const int b = r / T, t = r - b * T, g = b * NT + L + t;
    float* row = p.out + (size_t)r * D;
    const float* g5 = mod_ptr(p, 1, b, 5);
#pragma unroll
    for (int i = 0; i < 4; ++i) {
      const int col = (i * 64 + lane) * 4;
      f32x4 x = *(const f32x4*)(row + col);
      const u32x2 y0 = *(const u32x2*)(YS + (size_t)(2 * g) * D + col), y1 = *(const u32x2*)(YS + (size_t)(2 * g + 1) * D + col);
      const f32x4 gg = *(const f32x4*)(g5 + col);
      x[0] += gg[0] * (bf_lo(y0[0]) + bf_lo(y1[0])); x[1] += gg[1] * (bf_hi(y0[0]) + bf_hi(y1[0]));
      x[2] += gg[2] * (bf_lo(y0[1]) + bf_lo(y1[1])); x[3] += gg[3] * (bf_hi(y0[1]) + bf_hi(y1[1]));
      *(f32x4*)(row + col) = x;
    }
  }
}

__global__ void __launch_bounds__(NTHREADS, 2) mk_forward(Params p) {
  extern __shared__ __attribute__((aligned(16))) unsigned char smem[];
  volatile LAS unsigned* bst = (volatile LAS unsigned*)((LAS unsigned char*)smem + LDS_BYTES);
  if (threadIdx.x < 4) bst[threadIdx.x] = 0u;
  __syncthreads();
  const XcdBarrier gbar = xcd_barrier_post((unsigned*)(p.ws + WS_CTL), bst);
  phase_p0(p, smem);
  __syncthreads();
  conv_mixer(p, 0, smem);
  xcd_barrier(gbar);
#pragma unroll 1
  for (int step = 0; step < 22; ++step) {
    const int layer = step >= 11 ? 1 : 0, k = step - layer * 11;
    int gk = -1;
    switch (k) {
      case 0: phase_a0(p, layer); break;
      case 1: gk = GK_A1; break;
      case 2: phase_hg_b1(p, layer, smem); phase_attn(p, layer, smem); break;
      case 3: phase_hg_b2(p, layer, smem); break;
      case 4: phase_hg_b3(p, layer, smem); break;
      case 5: gk = GK_GATES; break;
      case 6: gk = GK_PROJ; break;
      case 7: gk = GK_OUT; break;
      case 8: phase_c3(p, layer, smem); if (layer == 0) { __syncthreads(); conv_mixer(p, 1, smem); } break;
      case 9: gk = GK_ACT; break;
      default: gk = GK_DOWN; break;
    }
    if (gk >= 0) {
      const GemmJob job = make_job(p, gk, layer, smem);
      pg8::gemm_phase<GemmJob>((LAS unsigned char*)smem, job);
    }
    xcd_barrier(gbar);
  }
  phase_final(p);
}

extern "C" void kernel_launch(void* const* d_in, const int* in_sizes, int n_in, void* d_out, int out_size, void* d_ws, size_t ws_size,
                              hipStream_t stream) {
  static int grid_blocks = 0;
  if (!grid_blocks) {
    int dev = 0, cus = 0, per_cu = 0;
    (void)hipGetDevice(&dev);
    (void)hipDeviceGetAttribute(&cus, hipDeviceAttributeMultiprocessorCount, dev);
    (void)hipFuncSetAttribute((const void*)mk_forward, hipFuncAttributeMaxDynamicSharedMemorySize, LDS_BYTES + 16);
    (void)hipOccupancyMaxActiveBlocksPerMultiprocessor(&per_cu, (const void*)mk_forward, NTHREADS, LDS_BYTES + 16);
    if (per_cu < 1) { fprintf(stderr, "kernel_launch: occupancy query reports %d blocks per CU\n", per_cu); per_cu = 1; }
    grid_blocks = cus;
    if (ws_size < WS_TOTAL) fprintf(stderr, "kernel_launch: workspace too small: %zu < %zu\n", ws_size, (size_t)WS_TOTAL);
  }
  Params p{};
  const float* const* in = (const float* const*)d_in;
  p.x = in[0]; p.c = in[1]; p.ctx = in[2]; p.c_ctx = in[3]; p.w_ada = in[4]; p.b_ada = in[5]; p.norm1 = in[6]; p.norm2 = in[7]; p.w_in = in[8];
  p.na_qn = in[9]; p.na_kn = in[10]; p.na_rpb = in[11]; p.hg_lower = in[12]; p.hg_norm = in[13]; p.wa_qn = in[14]; p.wa_kn = in[15]; p.wa_sink = in[16];
  p.w_pa = in[17]; p.w_pb = in[18]; p.w_pc = in[19]; p.w_out = in[20]; p.w_router = in[21]; p.b_router = in[22]; p.w_gate = in[23]; p.w_up = in[24]; p.w_down = in[25];
  p.out = (float*)d_out; p.ws = (unsigned char*)d_ws;
  (void)hipMemsetAsync((char*)d_ws + WS_CTL, 0, CTL_BYTES, stream);
  void* args[] = {&p};
  hipError_t e = hipLaunchCooperativeKernel((const void*)mk_forward, dim3(grid_blocks), dim3(NTHREADS), args, LDS_BYTES + 16, stream);
  if (e != hipSuccess) fprintf(stderr, "cooperative launch failed: %s (grid %d)\n", hipGetErrorString(e), grid_blocks);
}
```

```cpp
#include <hip/hip_runtime.h>
#include <cstdio>
#include <cstdint>

#define DI __device__ __forceinline__
typedef unsigned short bf16_t;
typedef short bf16x8 __attribute__((ext_vector_type(8)));
typedef short s16x4 __attribute__((ext_vector_type(4)));
typedef float f32x2 __attribute__((ext_vector_type(2)));
typedef float f32x4 __attribute__((ext_vector_type(4)));
typedef float f32x16 __attribute__((ext_vector_type(16)));
typedef unsigned u32x2 __attribute__((ext_vector_type(2)));
typedef unsigned u32x4 __attribute__((ext_vector_type(4)));
typedef __bf16 bf16x2_t __attribute__((ext_vector_type(2)));

constexpr int NB = 2, T = 8192, L = 256, NT = L + T, NTOK = NB * NT, D = 1024;
constexpr int INC = 7936;
constexpr int PCOLS = 4864;
constexpr int NCHUNK = NT / 64;
constexpr int NCHAIN = 16;
constexpr int NASSIGN = NTOK * 2;
constexpr float RMS_EPS = 1e-6f;
constexpr float LOG2E = 1.4426950408889634f;
constexpr int NTHREADS = 512;
constexpr int LDS_BYTES = 135168;

constexpr size_t al256(size_t x) { return (x + 255) & ~(size_t)255; }
constexpr size_t WS_CTL = 0;
constexpr size_t CTL_BYTES = 16384;
constexpr size_t WS_MOD = CTL_BYTES;
constexpr size_t WS_ROPE = al256(WS_MOD + 2 * 3 * 6144 * 4);
constexpr size_t WS_LB = al256(WS_ROPE + 2 * 128 * 16 * 4);
constexpr size_t WS_CNT = WS_CTL + 3456 * 4;
constexpr size_t WS_CTXR = al256(WS_LB + 2 * 2 * 512 * 4);
constexpr size_t WS_LIST = al256(WS_CTXR + (size_t)NB * L * D * 4);
constexpr size_t WS_WTS = al256(WS_LIST + (size_t)16 * NTOK * 4);
constexpr size_t WS_DEC = al256(WS_WTS + (size_t)NASSIGN * 4);
constexpr size_t WS_H = al256(WS_DEC + (size_t)NCHAIN * NCHUNK * 128 * 4);
constexpr size_t WS_Y = al256(WS_H + (size_t)NTOK * D * 2);
constexpr size_t WS_U = al256(WS_Y + (size_t)3 * NTOK * 512 * 2);
constexpr size_t WMIX_BYTES = (size_t)(PCOLS + 3072 + 1024) * D * 2 + (size_t)3 * 1024 * 512 * 2;
constexpr size_t WEXP_BYTES = (size_t)16 * (1024 * 1024 + 1024 * 512) * 2;
constexpr size_t WS_WMIX = al256(WS_U + (size_t)NCHAIN * NCHUNK * 16384 * 2);
constexpr size_t WS_WEXP = al256(WS_WMIX + WMIX_BYTES);
constexpr size_t WS_P = al256(WS_WEXP + WEXP_BYTES);
constexpr size_t WS_QA = WS_P;
constexpr size_t WS_KA = al256(WS_QA + (size_t)NTOK * 512 * 2);
constexpr size_t WS_VAT = al256(WS_KA + (size_t)NTOK * 512 * 2);
constexpr size_t WS_HG = al256(WS_VAT + (size_t)NTOK * 512 * 2);
constexpr size_t WS_QW = al256(WS_HG + (size_t)NTOK * 2560 * 2);
constexpr size_t WS_KW = al256(WS_QW + (size_t)NTOK * 512 * 2);
constexpr size_t WS_VWT = al256(WS_KW + (size_t)NTOK * 128 * 2);
constexpr size_t WS_PEND = al256(WS_VWT + (size_t)NTOK * 128 * 2);
constexpr size_t WS_G = WS_P;
constexpr size_t WS_MERGED = al256(WS_G + (size_t)NTOK * 3072 * 2);
constexpr size_t WS_MEND = al256(WS_MERGED + (size_t)NTOK * D * 2);
constexpr size_t WS_HX = WS_P;
constexpr size_t WS_ACT = al256(WS_HX + (size_t)NTOK * D * 2);
constexpr size_t WS_ACTEND = al256(WS_ACT + (size_t)(NASSIGN + 16 * 256) * 512 * 2);
static_assert(WS_MEND <= WS_PEND && WS_ACTEND <= WS_PEND, "P overlays");
constexpr size_t WS_YS = WS_U;
constexpr size_t WS_TOTAL = WS_PEND;
static_assert(WS_TOTAL < 400ull * 1000 * 1000, "workspace too large");
static_assert((size_t)NASSIGN * 1024 * 2 <= (size_t)NCHAIN * NCHUNK * 16384 * 2, "YS overlay");

struct Params {
  const float *x, *c, *ctx, *c_ctx, *w_ada, *b_ada, *norm1, *norm2, *w_in, *na_qn, *na_kn, *na_rpb, *hg_lower, *hg_norm,
      *wa_qn, *wa_kn, *wa_sink, *w_pa, *w_pb, *w_pc, *w_out, *w_router, *b_router, *w_gate, *w_up, *w_down;
  float* out;
  unsigned char* ws;
};

DI unsigned pk2(float lo, float hi) { f32x2 v = {lo, hi}; bf16x2_t r = __builtin_convertvector(v, bf16x2_t); return __builtin_bit_cast(unsigned, r); }
DI float bf_lo(unsigned u) { return __uint_as_float(u << 16); }
DI float bf_hi(unsigned u) { return __uint_as_float(u & 0xffff0000u); }
DI float bf2f(bf16_t h) { return __uint_as_float(((unsigned)h) << 16); }
DI bf16_t f2bf(float x) { return (bf16_t)(pk2(x, 0.f) & 0xffffu); }
DI int launder_tid() { int t = threadIdx.x; asm volatile("" : "+v"(t)); return t; }
DI int crow(int reg, int h) { return (reg & 3) + 8 * (reg >> 2) + 4 * h; }
DI float wave_sum(float v) {
#pragma unroll
  for (int o = 32; o >= 1; o >>= 1) v += __shfl_xor(v, o);
  return v;
}
DI float silu_f(float x) { return x / (1.f + __expf(-x)); }
DI float sigmoid_f(float x) { return 1.f / (1.f + __expf(-x)); }
DI f32x16 zero16() { f32x16 z; for (int i = 0; i < 16; ++i) z[i] = 0.f; return z; }
#define MFMA32(a, b, c) __builtin_amdgcn_mfma_f32_32x32x16_bf16((a), (b), (c), 0, 0, 0)
#define MFMA16(a, b, c) __builtin_amdgcn_mfma_f32_16x16x32_bf16((a), (b), (c), 0, 0, 0)


#define LAS __attribute__((address_space(3)))
#define XB_TMO      128
#define XB_XCNT(j)  (256  + 64 * (j))
#define XB_XSUB(j)  (1280 + 64 * (j))
#define XB_XGEN(j)  (2304 + 64 * (j))
#define XB_TOP      3328
#define XB_TOPGEN   3392
#define XCD_BAR_WORDS 3456
#define XB_SPIN_CAP (1u << 18)
DI unsigned xb_ld(unsigned* p) { return __hip_atomic_load(p, __ATOMIC_RELAXED, __HIP_MEMORY_SCOPE_AGENT); }
DI unsigned xb_add(unsigned* p, unsigned v) { return __hip_atomic_fetch_add(p, v, __ATOMIC_RELAXED, __HIP_MEMORY_SCOPE_AGENT); }
DI unsigned xb_xcc_id() { return (unsigned)__builtin_amdgcn_s_getreg((3 << 11) | 20) & 0xFu; }
#define XB_SPIN(cond, bar) do { unsigned _sp = 0; while (cond) { __builtin_amdgcn_s_sleep(1); \
    if ((++_sp & 255u) == 0u) { if (xb_ld(&(bar)[XB_TMO])) break; if (_sp > XB_SPIN_CAP) { atomicAdd(&(bar)[XB_TMO], 1u); break; } } } } while (0)
struct XcdBarrier { unsigned* bar; unsigned x; volatile LAS unsigned* st; };
DI XcdBarrier xcd_barrier_post(unsigned* bar, volatile LAS unsigned* st) {
  XcdBarrier b; b.bar = bar; b.x = xb_xcc_id(); b.st = st;
  if (threadIdx.x == 0) (void)xb_add(&bar[XB_XCNT(b.x)], 1u);
  return b;
}
DI void xcd_barrier_complete(unsigned* bar, unsigned x, unsigned& nloc, unsigned& nx) {
  const unsigned G = gridDim.x * gridDim.y * gridDim.z;
  unsigned sum, cnt, mine, sp = 0u;
  for (;;) {
    sum = 0u; cnt = 0u; mine = 0u;
#pragma unroll
    for (unsigned j = 0; j < 16; ++j) { const unsigned c = xb_ld(&bar[XB_XCNT(j)]); sum += c; cnt += (c > 0u) ? 1u : 0u; mine = (j == x) ? c : mine; }
    if (sum == G) break;
    __builtin_amdgcn_s_sleep(1);
    if ((++sp & 255u) == 0u) { if (xb_ld(&bar[XB_TMO])) break; if (sp > XB_SPIN_CAP) { atomicAdd(&bar[XB_TMO], 1u); break; } }
  }
  nloc = mine > 0u ? mine : 1u; nx = cnt > 0u ? cnt : 1u;
}
DI void xcd_barrier(const XcdBarrier& b) {
  asm volatile("s_waitcnt vmcnt(0)" ::: "memory");
  __syncthreads();
  if (threadIdx.x == 0) {
    unsigned* bar = b.bar;
    const unsigned bx = xb_xcc_id();
    __builtin_amdgcn_s_waitcnt(0);
    unsigned nloc = b.st[0], nx = b.st[1];
    if (nloc == 0u) { xcd_barrier_complete(bar, bx, nloc, nx); b.st[0] = nloc; b.st[1] = nx; }
    const unsigned old = xb_add(&bar[XB_XSUB(bx)], 1u);
    const unsigned gen = old / nloc;
    if (old + 1u == (gen + 1u) * nloc) {
      __builtin_amdgcn_fence(__ATOMIC_RELEASE, "agent");
      asm volatile("s_waitcnt vmcnt(0)" ::: "memory");
      const unsigned og = xb_add(&bar[XB_TOP], 1u);
      const unsigned tg = og / nx;
      if (og + 1u == (tg + 1u) * nx) xb_add(&bar[XB_TOPGEN], 1u);
      else XB_SPIN(xb_ld(&bar[XB_TOPGEN]) == tg, bar);
      __builtin_amdgcn_fence(__ATOMIC_ACQUIRE, "agent");
      xb_add(&bar[XB_XGEN(bx)], 1u);
      asm volatile("s_waitcnt vmcnt(0)" ::: "memory");
    } else {
      XB_SPIN(xb_ld(&bar[XB_XGEN(bx)]) == gen, bar);
      __builtin_amdgcn_fence(__ATOMIC_ACQUIRE, "agent");
      asm volatile("s_waitcnt vmcnt(0)" ::: "memory");
    }
  }
  __syncthreads();
}

DI const float* res_in_row(const Params& p, int layer, int g) {
  const int b = g / NT, n = g - b * NT;
  if (layer == 0) return n < L ? p.ctx + ((size_t)b * L + n) * D : p.x + ((size_t)b * T + (n - L)) * D;
  return n < L ? (const float*)(p.ws + WS_CTXR) + ((size_t)b * L + n) * D : p.out + ((size_t)b * T + (n - L)) * D;
}
DI float* res_out_row(const Params& p, int g) {
  const int b = g / NT, n = g - b * NT;
  return n < L ? (float*)(p.ws + WS_CTXR) + ((size_t)b * L + n) * D : p.out + ((size_t)b * T + (n - L)) * D;
}
DI int mod_vec(int g) { const int b = g / NT, n = g - b * NT; return n < L ? 2 : b; }
DI const float* mod_ptr(const Params& p, int layer, int v, int chunk) { return (const float*)(p.ws + WS_MOD) + ((size_t)(layer * 3 + v) * 6 + chunk) * D; }

__device__ void phase_p0(const Params& p, unsigned char* smem) {
  const int tid = launder_tid();
  float* sc = (float*)smem;
  float* red = sc + 3 * 1024;
  for (int i = tid; i < 3 * 1024; i += NTHREADS) {
    const int v = i >> 10, d = i & 1023;
    const float x = v == 0 ? p.c[d] : (v == 1 ? p.c[1024 + d] : p.c_ctx[d]);
    sc[i] = silu_f(x);
  }
  __syncthreads();
  for (int u = blockIdx.x; u < 2 * 96; u += gridDim.x) {
    const int layer = u / 96, j0 = (u % 96) * 64;
    const int col = tid & 63, ds = tid >> 6;
    const float* w = p.w_ada + ((size_t)layer * D + ds * 128) * 6144 + j0 + col;
    float a0 = 0.f, a1 = 0.f, a2 = 0.f;
#pragma unroll 8
    for (int d = 0; d < 128; ++d) {
      const float wv = w[(size_t)d * 6144];
      a0 += sc[ds * 128 + d] * wv; a1 += sc[1024 + ds * 128 + d] * wv; a2 += sc[2048 + ds * 128 + d] * wv;
    }
    red[(ds * 64 + col) * 3 + 0] = a0; red[(ds * 64 + col) * 3 + 1] = a1; red[(ds * 64 + col) * 3 + 2] = a2;
    __syncthreads();
    if (tid < 192) {
      const int v = tid / 64, cc = tid & 63;
      float s = p.b_ada[layer * 6144 + j0 + cc];
      for (int k = 0; k < 8; ++k) s += red[(k * 64 + cc) * 3 + v];
      ((float*)(p.ws + WS_MOD))[(size_t)(layer * 3 + v) * 6144 + j0 + cc] = s;
    }
    __syncthreads();
  }
  const int gt = blockIdx.x * NTHREADS + tid, nth = gridDim.x * NTHREADS;
  float* rope = (float*)(p.ws + WS_ROPE);
  for (int i = gt; i < 128 * 16; i += nth) {
    const int pos = i >> 4, k = i & 15;
    const float inv = powf(10000.0f, -(float)k / 16.0f);
    float sn, cs; sincosf((float)pos * inv, &sn, &cs);
    rope[i] = cs; rope[2048 + i] = sn;
  }
  float* lb = (float*)(p.ws + WS_LB);
  for (int i = gt; i < 2 * 2 * 512; i += nth) {
    const int layer = i >> 10, dir = (i >> 9) & 1, ch = i & 511;
    const float h0 = p.hg_lower[(dir * 2 + 0) * 512 + ch], h1 = p.hg_lower[(dir * 2 + 1) * 512 + ch];
    lb[i] = layer == 0 ? 0.f : 1.f / (1.f + expf(h0 - h1));
  }
}

__device__ void phase_a0(const Params& p, int layer) {
  const int tid_ = launder_tid(), lane = tid_ & 63, wave = tid_ >> 6;
  const float* nw = p.norm1 + layer * D;
  bf16_t* H = (bf16_t*)(p.ws + WS_H);
  const bf16_t* YS = (const bf16_t*)(p.ws + WS_YS);
  for (int g = blockIdx.x * 8 + wave; g < NTOK; g += gridDim.x * 8) {
    const float* src = res_in_row(p, layer, g);
    const int v = mod_vec(g);
    f32x4 x[4];
#pragma unroll
    for (int i = 0; i < 4; ++i) x[i] = *(const f32x4*)(src + (i * 64 + lane) * 4);
    if (layer > 0) {
      const float* g5 = mod_ptr(p, layer - 1, v, 5);
      float* dst = res_out_row(p, g);
#pragma unroll
      for (int i = 0; i < 4; ++i) {
        const int col = (i * 64 + lane) * 4;
        const u32x2 y0 = *(const u32x2*)(YS + (size_t)(2 * g) * D + col), y1 = *(const u32x2*)(YS + (size_t)(2 * g + 1) * D + col);
        const f32x4 gg = *(const f32x4*)(g5 + col);
        x[i][0] += gg[0] * (bf_lo(y0[0]) + bf_lo(y1[0])); x[i][1] += gg[1] * (bf_hi(y0[0]) + bf_hi(y1[0]));
        x[i][2] += gg[2] * (bf_lo(y0[1]) + bf_lo(y1[1])); x[i][3] += gg[3] * (bf_hi(y0[1]) + bf_hi(y1[1]));
        *(f32x4*)(dst + col) = x[i];
      }
    }
    float ss = 0.f;
#pragma unroll
    for (int i = 0; i < 4; ++i) ss += x[i][0] * x[i][0] + x[i][1] * x[i][1] + x[i][2] * x[i][2] + x[i][3] * x[i][3];
    ss = wave_sum(ss);
    const float r = rsqrtf(ss * (1.f / D) + RMS_EPS);
    const float* sh = mod_ptr(p, layer, v, 0);
    const float* scl = mod_ptr(p, layer, v, 1);
#pragma unroll
    for (int i = 0; i < 4; ++i) {
      const int col = (i * 64 + lane) * 4;
      const f32x4 w4 = *(const f32x4*)(nw + col), s4 = *(const f32x4*)(sh + col), c4 = *(const f32x4*)(scl + col);
      float y[4];
#pragma unroll
      for (int k = 0; k < 4; ++k) y[k] = x[i][k] * r * w4[k] * (1.f + c4[k]) + s4[k];
      u32x2 o; o[0] = pk2(y[0], y[1]); o[1] = pk2(y[2], y[3]);
      *(u32x2*)(H + (size_t)g * D + col) = o;
    }
  }
}


struct AttnSt { f32x16 o0, o1; float m, l; };
DI void attn_init(AttnSt& st) { st.o0 = zero16(); st.o1 = zero16(); st.m = -1e30f; st.l = 0.f; }
DI void load_q(bf16x8 (&qf)[4], const bf16_t* qp) {
#pragma unroll
  for (int ks = 0; ks < 4; ++ks) qf[ks] = *(const bf16x8*)(qp + ks * 16);
}
DI void load_kv(bf16x8 (&kf)[4], u32x4 (&vf)[2][2], const bf16_t* kp  , const bf16_t* vp  ) {
#pragma unroll
  for (int ks = 0; ks < 4; ++ks) kf[ks] = *(const bf16x8*)(kp + ks * 16);
#pragma unroll
  for (int ks = 0; ks < 2; ++ks)
#pragma unroll
    for (int dt = 0; dt < 2; ++dt) {
      const u32x2 lo = *(const u32x2*)(vp + (size_t)dt * 32 * NT + ks * 16), hi = *(const u32x2*)(vp + (size_t)dt * 32 * NT + ks * 16 + 8);
      vf[ks][dt][0] = lo[0]; vf[ks][dt][1] = lo[1]; vf[ks][dt][2] = hi[0]; vf[ks][dt][3] = hi[1];
    }
}
DI f32x16 qk_tile(const bf16x8 (&kf)[4], const bf16x8 (&qf)[4]) {
  f32x16 s = zero16();
#pragma unroll
  for (int ks = 0; ks < 4; ++ks) s = MFMA32(kf[ks], qf[ks], s);
  return s;
}
DI void softmax_pv(AttnSt& st, const f32x16& s, const u32x4 (&vf)[2][2]) {
  float tm = s[0];
#pragma unroll
  for (int r = 1; r < 16; ++r) tm = fmaxf(tm, s[r]);
  tm = fmaxf(tm, __shfl_xor(tm, 32));
  const float mn = fmaxf(st.m, tm);
  const float alpha = __builtin_amdgcn_exp2f(st.m - mn);
  float pv[16]; float rs = 0.f;
#pragma unroll
  for (int r = 0; r < 16; ++r) { pv[r] = __builtin_amdgcn_exp2f(s[r] - mn); rs += pv[r]; }
  rs += __shfl_xor(rs, 32);
  st.l = st.l * alpha + rs; st.m = mn;
#pragma unroll
  for (int r = 0; r < 16; ++r) { st.o0[r] *= alpha; st.o1[r] *= alpha; }
#pragma unroll
  for (int ks = 0; ks < 2; ++ks) {
    u32x4 pp; pp[0] = pk2(pv[8 * ks], pv[8 * ks + 1]); pp[1] = pk2(pv[8 * ks + 2], pv[8 * ks + 3]); pp[2] = pk2(pv[8 * ks + 4], pv[8 * ks + 5]); pp[3] = pk2(pv[8 * ks + 6], pv[8 * ks + 7]);
    const bf16x8 pf = __builtin_bit_cast(bf16x8, pp);
    st.o0 = MFMA32(__builtin_bit_cast(bf16x8, vf[ks][0]), pf, st.o0);
    st.o1 = MFMA32(__builtin_bit_cast(bf16x8, vf[ks][1]), pf, st.o1);
  }
}
DI void attn_store(const AttnSt& st, bf16_t* dst, int h) {
  const float inv = 1.f / st.l;
#pragma unroll
  for (int q = 0; q < 4; ++q) {
    u32x2 o; o[0] = pk2(st.o0[4 * q] * inv, st.o0[4 * q + 1] * inv); o[1] = pk2(st.o0[4 * q + 2] * inv, st.o0[4 * q + 3] * inv);
    *(u32x2*)(dst + 8 * q + 4 * h) = o;
    u32x2 o2; o2[0] = pk2(st.o1[4 * q] * inv, st.o1[4 * q + 1] * inv); o2[1] = pk2(st.o1[4 * q + 2] * inv, st.o1[4 * q + 3] * inv);
    *(u32x2*)(dst + 32 + 8 * q + 4 * h) = o2;
  }
}
DI void attn_sink(AttnSt& st, float sk) {
  const float mf = fmaxf(st.m, sk), a = __builtin_amdgcn_exp2f(st.m - mf);
  st.l = st.l * a + __builtin_amdgcn_exp2f(sk - mf); st.m = mf;
#pragma unroll
  for (int rg = 0; rg < 16; ++rg) { st.o0[rg] *= a; st.o1[rg] *= a; }
}
DI void scale_plain(f32x16& s) {
#pragma unroll
  for (int r = 0; r < 16; ++r) s[r] *= 0.125f * LOG2E;
}
DI void attn_ctx_tiles2(AttnSt& sa, AttnSt& sb, const bf16x8 (&qa)[4], const bf16x8 (&qb)[4], const bf16_t* kbase, int kstride, const bf16_t* vbase, int lane) {
  const int h = lane >> 5, ql = lane & 31;
#pragma unroll 1
  for (int i = 0; i < 8; ++i) {
    bf16x8 kf[4]; u32x4 vf[2][2];
    load_kv(kf, vf, kbase + (size_t)(32 * i + ql) * kstride + 8 * h, vbase + (size_t)ql * NT + 32 * i + 4 * h);
    f32x16 s0 = qk_tile(kf, qa), s1 = qk_tile(kf, qb);
    scale_plain(s0); scale_plain(s1);
    softmax_pv(sa, s0, vf); softmax_pv(sb, s1, vf);
  }
}

__device__ void phase_attn(const Params& p, int layer, unsigned char* smem) {
  const int tid_ = launder_tid(), lane = tid_ & 63, wave = tid_ >> 6, h = lane >> 5, ql = lane & 31;
  const bf16_t* QA = (const bf16_t*)(p.ws + WS_QA); const bf16_t* KA = (const bf16_t*)(p.ws + WS_KA); const bf16_t* VAT = (const bf16_t*)(p.ws + WS_VAT);
  const bf16_t* QW = (const bf16_t*)(p.ws + WS_QW); const bf16_t* KW = (const bf16_t*)(p.ws + WS_KW); const bf16_t* VWT = (const bf16_t*)(p.ws + WS_VWT);
  bf16_t* YA = (bf16_t*)(p.ws + WS_Y); bf16_t* YC = YA + (size_t)2 * NTOK * 512;
  const float NEG_INF = -__builtin_inff();
  constexpr int NU_NA = NB * 8 * 128, NU_WA = NB * 2 * (T / 32) * 2, NU_C = NB * 8 * 4;
  const int nunits = NU_NA + NU_WA + (layer == 0 ? 2 * NU_C : 0);
#pragma unroll 1
  for (int u = blockIdx.x * 8 + wave; u < nunits; u += gridDim.x * 8) {
    AttnSt sa, sb; attn_init(sa); attn_init(sb);
    bf16x8 qa[4], qb[4];
    if (u < NU_NA) {
      const int r = u & 127, head = (u >> 7) & 7, b = u >> 10;
      const int gq = b * NT + L + r * 64 + ql;
      load_q(qa, QA + (size_t)gq * 512 + head * 64 + 8 * h);
      load_q(qb, QA + (size_t)(gq + 32) * 512 + head * 64 + 8 * h);
      const bf16_t* kb = KA + (size_t)b * NT * 512 + head * 64;
      const bf16_t* vb = VAT + (size_t)(b * 8 + head) * 64 * NT;
      const int rs = min(max(r - 4, 0), 120);
      const int cqa = ql, cqb = 32 + ql;
      const int loa = min(max(cqa - 8, 0), 48), lob = min(max(cqb - 8, 0), 48);
      float* rpb = (float*)(smem + wave * 2048);
      { const float* rg_ = p.na_rpb + (size_t)(layer * 8 + head) * 15 * 31;
#pragma unroll
        for (int i_ = 0; i_ < 8; ++i_) { const int j_ = lane + 64 * i_; if (j_ < 465) rpb[j_] = rg_[j_]; } }
#pragma unroll 1
      for (int t = 0; t < 16; ++t) {
        const int kr = rs + (t >> 1), half = t & 1;
        const int n0 = L + kr * 64 + half * 32;
        bf16x8 kf[4]; u32x4 vf[2][2];
        load_kv(kf, vf, kb + (size_t)(n0 + ql) * 512 + 8 * h, vb + (size_t)ql * NT + n0 + 4 * h);
        const float* brow = rpb + (kr - r + 7) * 31;
        f32x16 s0 = qk_tile(kf, qa), s1 = qk_tile(kf, qb);
#pragma unroll
        for (int rg = 0; rg < 16; ++rg) {
          const int kc = half * 32 + crow(rg, h);
          const bool oka = kc >= loa && kc < loa + 16, okb = kc >= lob && kc < lob + 16;
          const float ba = brow[min(max(kc - cqa + 15, 0), 30)], bb = brow[min(max(kc - cqb + 15, 0), 30)];
          s0[rg] = oka ? (s0[rg] * 0.125f + ba) * LOG2E : NEG_INF;
          s1[rg] = okb ? (s1[rg] * 0.125f + bb) * LOG2E : NEG_INF;
        }
        softmax_pv(sa, s0, vf); softmax_pv(sb, s1, vf);
      }
      attn_ctx_tiles2(sa, sb, qa, qb, kb, 512, vb, lane);
      attn_store(sa, YA + (size_t)gq * 512 + head * 64, h);
      attn_store(sb, YA + (size_t)(gq + 32) * 512 + head * 64, h);
    } else if (u < NU_NA + NU_WA) {
      const int uu = u - NU_NA;
      const int qt = uu & 255, hp = (uu >> 8) & 1, kv = (uu >> 9) & 1, b = uu >> 10;
      const int ha = kv * 4 + hp * 2, hb = ha + 1;
      const int q0 = qt * 32, gq = b * NT + L + q0 + ql;
      load_q(qa, QW + (size_t)gq * 512 + ha * 64 + 8 * h);
      load_q(qb, QW + (size_t)gq * 512 + hb * 64 + 8 * h);
      const bf16_t* kb = KW + (size_t)b * NT * 128 + kv * 64;
      const bf16_t* vb = VWT + (size_t)(b * 2 + kv) * 64 * NT;
#pragma unroll 1
      for (int i = 0; i < 9; ++i) {
        const int k0 = q0 - 128 + 32 * i;
        if (k0 < 0 || k0 >= T) continue;
        bf16x8 kf[4]; u32x4 vf[2][2];
        load_kv(kf, vf, kb + (size_t)(L + k0 + ql) * 128 + 8 * h, vb + (size_t)ql * NT + L + k0 + 4 * h);
        f32x16 s0 = qk_tile(kf, qa), s1 = qk_tile(kf, qb);
#pragma unroll
        for (int rg = 0; rg < 16; ++rg) {
          const int dlt = (k0 + crow(rg, h)) - (q0 + ql);
          const bool ok = dlt <= 128 && dlt >= -128;
          s0[rg] = ok ? s0[rg] * (0.125f * LOG2E) : NEG_INF;
          s1[rg] = ok ? s1[rg] * (0.125f * LOG2E) : NEG_INF;
        }
        softmax_pv(sa, s0, vf); softmax_pv(sb, s1, vf);
      }
      attn_ctx_tiles2(sa, sb, qa, qb, kb, 128, vb, lane);
      attn_sink(sa, p.wa_sink[layer * 8 + ha] * LOG2E); attn_sink(sb, p.wa_sink[layer * 8 + hb] * LOG2E);
      attn_store(sa, YC + (size_t)gq * 512 + ha * 64, h);
      attn_store(sb, YC + (size_t)gq * 512 + hb * 64, h);
    } else if (u < NU_NA + NU_WA + NU_C) {
      const int uu = u - NU_NA - NU_WA;
      const int qp = uu & 3, head = (uu >> 2) & 7, b = uu >> 5;
      const int gq = b * NT + qp * 64 + ql;
      load_q(qa, QA + (size_t)gq * 512 + head * 64 + 8 * h);
      load_q(qb, QA + (size_t)(gq + 32) * 512 + head * 64 + 8 * h);
      attn_ctx_tiles2(sa, sb, qa, qb, KA + (size_t)b * NT * 512 + head * 64, 512, VAT + (size_t)(b * 8 + head) * 64 * NT, lane);
      attn_store(sa, YA + (size_t)gq * 512 + head * 64, h);
      attn_store(sb, YA + (size_t)(gq + 32) * 512 + head * 64, h);
    } else {
      const int uu = u - NU_NA - NU_WA - NU_C;
      const int qt = uu & 7, hp = (uu >> 3) & 1, kv = (uu >> 4) & 1, b = uu >> 5;
      const int ha = kv * 4 + hp * 2, hb = ha + 1;
      const int gq = b * NT + qt * 32 + ql;
      load_q(qa, QW + (size_t)gq * 512 + ha * 64 + 8 * h);
      load_q(qb, QW + (size_t)gq * 512 + hb * 64 + 8 * h);
      attn_ctx_tiles2(sa, sb, qa, qb, KW + (size_t)b * NT * 128 + kv * 64, 128, VWT + (size_t)(b * 2 + kv) * 64 * NT, lane);
      attn_sink(sa, p.wa_sink[layer * 8 + ha] * LOG2E); attn_sink(sb, p.wa_sink[layer * 8 + hb] * LOG2E);
      attn_store(sa, YC + (size_t)gq * 512 + ha * 64, h);
      attn_store(sb, YC + (size_t)gq * 512 + hb * 64, h);
    }
  }
}

DI int perm32(int rho) { return 8 * ((rho >> 2) & 3) + 4 * (rho >> 4) + (rho & 3); }
DI void conv_item(const float* W, int ldw, int k0, int c0, bf16_t* dst  , int Kd, float* scr, int lane, bool perm) {
  const float* wp = W + (size_t)(k0 + (lane >> 5)) * ldw + c0 + (lane & 31);
  float v[32];
#pragma unroll
  for (int i = 0; i < 32; ++i) v[i] = wp[(size_t)(2 * i) * ldw];
#pragma unroll
  for (int i = 0; i < 32; ++i) scr[(2 * i + (lane >> 5)) * 33 + (lane & 31)] = v[i];
  asm volatile("s_waitcnt lgkmcnt(0)" ::: "memory");
  const int c = lane & 7;
#pragma unroll
  for (int j = 0; j < 4; ++j) {
    const int n = (lane >> 3) + 8 * j; const float* s = scr + (8 * c) * 33 + (perm ? perm32(n) : n);
    u32x4 o; o[0] = pk2(s[0 * 33], s[1 * 33]); o[1] = pk2(s[2 * 33], s[3 * 33]); o[2] = pk2(s[4 * 33], s[5 * 33]); o[3] = pk2(s[6 * 33], s[7 * 33]);
    *(u32x4*)(dst + (size_t)n * Kd + k0 + 8 * c) = o;
  }
  asm volatile("s_waitcnt lgkmcnt(0)" ::: "memory");
}
constexpr size_t WM_WIN = 0, WM_WG = WM_WIN + (size_t)PCOLS * D * 2, WM_WP = WM_WG + (size_t)3072 * D * 2, WM_WO = WM_WP + (size_t)3 * 1024 * 512 * 2, WM_END = WM_WO + (size_t)D * D * 2;
static_assert(WM_END <= WMIX_BYTES, "mixer weight buffer");
__device__ void conv_mixer(const Params& p, int layer, unsigned char* smem) {
  const int tid = launder_tid(), lane = tid & 63, wave = tid >> 6;
  float* scr = (float*)smem + wave * (64 * 33);
  unsigned char* wm = p.ws + WS_WMIX;
  const float* Win = p.w_in + (size_t)layer * D * INC;
  constexpr int I_IN = 16 * (PCOLS / 32), I_G = 16 * (3072 / 32), I_P = 8 * 32, I_O = 16 * 32;
  for (int it = blockIdx.x * 8 + wave; it < I_IN + I_G + 3 * I_P + I_O; it += gridDim.x * 8) {
    int r = it;
    if (r < I_IN) {
      const int kb = r / (PCOLS / 32), rb = r % (PCOLS / 32), rho0 = rb * 32;
      const int tile = rho0 >> 8, bj = (rho0 >> 7) & 1, wc = (rho0 >> 5) & 3;
      conv_item(Win, INC, kb * 64, tile * 256 + 64 * wc + 32 * bj, (bf16_t*)(wm + WM_WIN) + (size_t)rho0 * D, D, scr, lane, tile >= 6 && tile < 16); continue;
    }
    r -= I_IN;
    if (r < I_G) { const int kb = r / 96, rb = r % 96; conv_item(Win, INC, kb * 64, PCOLS + rb * 32, (bf16_t*)(wm + WM_WG) + (size_t)rb * 32 * D, D, scr, lane, true); continue; }
    r -= I_G;
    if (r < 3 * I_P) {
      const int br = r / I_P, q = r % I_P, kb = q / 32, rb = q % 32;
      const float* Wp = (br == 0 ? p.w_pa : (br == 1 ? p.w_pb : p.w_pc)) + (size_t)layer * 512 * D;
      conv_item(Wp, D, kb * 64, rb * 32, (bf16_t*)(wm + WM_WP) + (size_t)br * 1024 * 512 + (size_t)rb * 32 * 512, 512, scr, lane, true); continue;
    }
    r -= 3 * I_P;
    { const int kb = r / 32, rb = r % 32; conv_item(p.w_out + (size_t)layer * D * D, D, kb * 64, rb * 32, (bf16_t*)(wm + WM_WO) + (size_t)rb * 32 * D, D, scr, lane, false); }
  }
}
constexpr size_t WE_PER = (size_t)1024 * 1024 * 2 + (size_t)1024 * 512 * 2;
static_assert(16 * WE_PER <= WEXP_BYTES, "expert weight buffer");
__device__ void conv_experts(const Params& p, int layer, unsigned char* smem, int nwaves) {
  const int tid = launder_tid(), lane = tid & 63, wave = tid >> 6;
  float* scr = (float*)smem + wave * (64 * 33);
  constexpr int I_GU = 16 * 32, I_D = 8 * 32;
  for (int it = blockIdx.x * nwaves + wave; it < 16 * (I_GU + I_D); it += gridDim.x * nwaves) {
    const int e = it / (I_GU + I_D); int r = it % (I_GU + I_D);
    unsigned char* we = p.ws + WS_WEXP + (size_t)e * WE_PER;
    if (r < I_GU) {
      const int kb = r / 32, rb = r % 32, rho0 = rb * 32, t = rho0 >> 8, bj = (rho0 >> 7) & 1, wc = (rho0 >> 5) & 3;
      const float* W = (bj ? p.w_up : p.w_gate) + ((size_t)(layer * 16 + e) * D) * 512;
      conv_item(W, 512, kb * 64, 128 * t + 32 * wc, (bf16_t*)we + (size_t)rho0 * D, D, scr, lane, true);
    } else {
      r -= I_GU; const int kb = r / 32, rb = r % 32;
      conv_item(p.w_down + ((size_t)(layer * 16 + e) * 512) * D, D, kb * 64, rb * 32, (bf16_t*)(we + (size_t)1024 * 1024 * 2) + (size_t)rb * 32 * 512, 512, scr, lane, true);
    }
  }
}


DI int hg_tokblock(int dir, int c) { return dir == 0 ? c : (c < 4 ? 3 - c : 135 - c); }
DI int hg_chunk_of_block(int dir, int tb) { return dir == 0 ? tb : (tb < 4 ? 3 - tb : 135 - tb); }
constexpr int HP = 136;
constexpr int TP = 72;
constexpr int H_QE = 0, H_QR = H_QE + 64 * HP * 2, H_KR = H_QR + 64 * HP * 2, H_VT = H_KR + 4 * 64 * HP * 2, H_ATT = H_VT + 128 * TP * 2,
              H_SEG = H_ATT + 64 * TP * 2, H_RED = H_SEG + 4 * 128 * 4, H_END = H_RED + 2 * 4 * 32 * 4;
static_assert(H_END <= LDS_BYTES, "LDS");
constexpr int H1_KET = 0, H1_VT = H1_KET + 128 * TP * 2, H1_SEG = H1_VT + 128 * TP * 2;

DI float hg_gates(const bf16_t* fp  , float lbv, int dir, float (&kk)[16], float (&bl)[16]) {
  float lf[16];
#pragma unroll
  for (int i = 0; i < 16; ++i) {
    const float x = bf2f(fp[(size_t)i * 2560]);
    const float f = lbv + (1.f - lbv) * sigmoid_f(x);
    lf[i] = __logf(fmaxf(f, 1e-30f)); kk[i] = 1.f - f;
  }
  float run = 0.f;
  if (dir == 0) {
#pragma unroll
    for (int i = 0; i < 16; ++i) { run += lf[i]; bl[i] = run; }
  } else {
#pragma unroll
    for (int i = 15; i >= 0; --i) { run += lf[i]; bl[i] = run; }
  }
  return run;
}
DI float hg_gates_raw(const unsigned short (&raw)[16], float lbv, int dir, float (&kk)[16], float (&bl)[16]) {
  float lf[16];
#pragma unroll
  for (int i = 0; i < 16; ++i) {
    const float f = lbv + (1.f - lbv) * sigmoid_f(bf2f(raw[i]));
    lf[i] = __logf(fmaxf(f, 1e-30f)); kk[i] = 1.f - f;
  }
  float run = 0.f;
  if (dir == 0) {
#pragma unroll
    for (int i = 0; i < 16; ++i) { run += lf[i]; bl[i] = run; }
  } else {
#pragma unroll
    for (int i = 15; i >= 0; --i) { run += lf[i]; bl[i] = run; }
  }
  return run;
}
DI void pack16_store(bf16_t* dst, const float (&v)[16]) {
  u32x4 a, b;
#pragma unroll
  for (int i = 0; i < 4; ++i) { a[i] = pk2(v[2 * i], v[2 * i + 1]); b[i] = pk2(v[8 + 2 * i], v[8 + 2 * i + 1]); }
  *(u32x4*)dst = a; *(u32x4*)(dst + 8) = b;
}
DI void hg_load_vt(bf16_t* Vt, const bf16_t* HG, int g0, int head, int tid) {
  const int dv = tid & 127, seg = tid >> 7;
  const bf16_t* vp = HG + (size_t)(g0 + 16 * seg) * 2560 + 1536 + head * 128 + dv;
  unsigned short raw[16];
#pragma unroll
  for (int i = 0; i < 16; ++i) raw[i] = vp[(size_t)i * 2560];
  u32x4 a, b;
#pragma unroll
  for (int i = 0; i < 4; ++i) { a[i] = (unsigned)raw[2 * i] | ((unsigned)raw[2 * i + 1] << 16); b[i] = (unsigned)raw[8 + 2 * i] | ((unsigned)raw[8 + 2 * i + 1] << 16); }
  *(u32x4*)(Vt + dv * TP + 16 * seg) = a; *(u32x4*)(Vt + dv * TP + 16 * seg + 8) = b;
}

__device__ void phase_hg_b1(const Params& p, int layer, unsigned char* smem) {
  const int tid = launder_tid(), lane = tid & 63, wave = tid >> 6, h = lane >> 5;
  const bf16_t* HG = (const bf16_t*)(p.ws + WS_HG);
  bf16_t* U = (bf16_t*)(p.ws + WS_U);
  float* DEC = (float*)(p.ws + WS_DEC);
  const float* LB = (const float*)(p.ws + WS_LB);
  bf16_t* KeT = (bf16_t*)(smem + H1_KET); bf16_t* Vt = (bf16_t*)(smem + H1_VT); float* segt = (float*)(smem + H1_SEG);
  const int cch = tid & 127, seg = tid >> 7;
  unsigned short rf_[16], rv_[16];
#define B1_ISSUE(u_) { const int chain_ = (u_) / NCHUNK, c_ = (u_) - chain_ * NCHUNK, head_ = chain_ & 3, dir_ = (chain_ >> 2) & 1, b_ = chain_ >> 3; \
    const bf16_t* bp_ = HG + (size_t)(b_ * NT + 64 * hg_tokblock(dir_, c_) + 16 * seg) * 2560 + head_ * 128 + cch; \
    _Pragma("unroll") for (int i_ = 0; i_ < 16; ++i_) { rf_[i_] = bp_[(size_t)i_ * 2560 + 512 * (1 + dir_)]; rv_[i_] = bp_[(size_t)i_ * 2560 + 1536]; } }
  if ((int)blockIdx.x < NCHAIN * NCHUNK) B1_ISSUE((int)blockIdx.x);
#pragma unroll 1
  for (int u = blockIdx.x; u < NCHAIN * NCHUNK; u += gridDim.x) {
    const int chain = u / NCHUNK, c = u - chain * NCHUNK;
    const int head = chain & 3, dir = (chain >> 2) & 1;
    float kk[16], bl[16];
    const float lbv = LB[layer * 1024 + dir * 512 + head * 128 + cch];
    const float tot = hg_gates_raw(rf_, lbv, dir, kk, bl);
    segt[seg * 128 + cch] = tot;
    {
      u32x4 a, b2;
#pragma unroll
      for (int i = 0; i < 4; ++i) { a[i] = (unsigned)rv_[2 * i] | ((unsigned)rv_[2 * i + 1] << 16); b2[i] = (unsigned)rv_[8 + 2 * i] | ((unsigned)rv_[8 + 2 * i + 1] << 16); }
      *(u32x4*)(Vt + cch * TP + 16 * seg) = a; *(u32x4*)(Vt + cch * TP + 16 * seg + 8) = b2;
    }
    if (u + (int)gridDim.x < NCHAIN * NCHUNK) B1_ISSUE(u + (int)gridDim.x);
    __syncthreads();
    const float t0 = segt[cch], t1 = segt[128 + cch], t2 = segt[256 + cch], t3 = segt[384 + cch];
    const float btot = (t0 + t1) + (t2 + t3);
    float pre;
    if (dir == 0) pre = seg == 0 ? 0.f : (seg == 1 ? t0 : (seg == 2 ? t0 + t1 : t0 + t1 + t2));
    else pre = seg == 3 ? 0.f : (seg == 2 ? t3 : (seg == 1 ? t3 + t2 : t3 + t2 + t1));
    float ke[16];
#pragma unroll
    for (int i = 0; i < 16; ++i) ke[i] = kk[i] * __expf(btot - (pre + bl[i]));
    pack16_store(KeT + cch * TP + 16 * seg, ke);
    if (seg == 0) DEC[(size_t)u * 128 + cch] = __expf(btot);
    __syncthreads();
    const int dkt = wave & 3;
#pragma unroll
    for (int k2 = 0; k2 < 2; ++k2) {
      const int dvt = 2 * (wave >> 2) + k2;
      f32x16 acc = zero16();
#pragma unroll
      for (int ks = 0; ks < 4; ++ks) {
        const bf16x8 af = *(const bf16x8*)(KeT + (dkt * 32 + (lane & 31)) * TP + ks * 16 + 8 * h);
        const bf16x8 bfr = *(const bf16x8*)(Vt + (dvt * 32 + (lane & 31)) * TP + ks * 16 + 8 * h);
        acc = MFMA32(af, bfr, acc);
      }
      bf16_t* dst = U + (size_t)u * 16384 + (size_t)(dvt * 32 + (lane & 31)) * 128 + dkt * 32;
#pragma unroll
      for (int q = 0; q < 4; ++q) {
        u32x2 o; o[0] = pk2(acc[4 * q], acc[4 * q + 1]); o[1] = pk2(acc[4 * q + 2], acc[4 * q + 3]);
        *(u32x2*)(dst + 8 * q + 4 * h) = o;
      }
    }
    __syncthreads();
  }
}

#undef B1_ISSUE
__device__ void phase_hg_b2(const Params& p, int layer, unsigned char* smem) {
  const int tid = launder_tid(), wave = tid >> 6;
  if (wave < 4) { conv_experts(p, layer, smem, 4); return; }
  unsigned* U32 = (unsigned*)(p.ws + WS_U);
  const float* DEC = (const float*)(p.ws + WS_DEC);
  const int gt = blockIdx.x * 256 + (tid - 256), nth = gridDim.x * 256;
  for (int idx = gt; idx < NCHAIN * 8192; idx += nth) {
    const int chain = idx >> 13, e2 = idx & 8191, dk = (2 * e2) & 127;
    unsigned* up = U32 + (size_t)chain * NCHUNK * 8192 + e2;
    const float* dp = DEC + (size_t)chain * NCHUNK * 128 + dk;
    float s0 = 0.f, s1 = 0.f;
    for (int c0 = 0; c0 < NCHUNK; c0 += 12) {
      unsigned uv[12]; f32x2 dv[12];
#pragma unroll
      for (int k = 0; k < 12; ++k) { uv[k] = up[(size_t)(c0 + k) * 8192]; dv[k] = *(const f32x2*)(dp + (c0 + k) * 128); }
#pragma unroll
      for (int k = 0; k < 12; ++k) {
        up[(size_t)(c0 + k) * 8192] = pk2(s0, s1);
        s0 = dv[k][0] * s0 + bf_lo(uv[k]); s1 = dv[k][1] * s1 + bf_hi(uv[k]);
      }
    }
  }
}

__device__ void phase_hg_b3(const Params& p, int layer, unsigned char* smem) {
  const int tid = launder_tid(), lane = tid & 63, wave = tid >> 6, h = lane >> 5;
  const bf16_t* HG = (const bf16_t*)(p.ws + WS_HG);
  const bf16_t* U = (const bf16_t*)(p.ws + WS_U);
  const float* LB = (const float*)(p.ws + WS_LB);
  bf16_t* YB = (bf16_t*)(p.ws + WS_Y) + (size_t)NTOK * 512;
  bf16_t* Qe = (bf16_t*)(smem + H_QE); bf16_t* Qr = (bf16_t*)(smem + H_QR); bf16_t* Kr = (bf16_t*)(smem + H_KR);
  bf16_t* Vt = (bf16_t*)(smem + H_VT); bf16_t* Att = (bf16_t*)(smem + H_ATT); float* segt = (float*)(smem + H_SEG); float* red = (float*)(smem + H_RED);
  const int cch = tid & 127, seg = tid >> 7;
  const int ntb = layer == 1 ? NCHUNK - 4 : NCHUNK;
  for (int u = blockIdx.x; u < NB * 4 * ntb; u += gridDim.x) {
    const int tb = u % ntb + (NCHUNK - ntb), head = (u / ntb) & 3, b = u / (4 * ntb);
    const int g0 = b * NT + 64 * tb;
    const int dvt = wave & 3, it = wave >> 2;
    unsigned short rv_[16], rq_[16], rf0_[16], rf1_[16];
    {
      const bf16_t* bp = HG + (size_t)(g0 + 16 * seg) * 2560 + head * 128 + cch;
#pragma unroll
      for (int i = 0; i < 16; ++i) { rv_[i] = bp[(size_t)i * 2560 + 1536]; rq_[i] = bp[(size_t)i * 2560]; rf0_[i] = bp[(size_t)i * 2560 + 512]; rf1_[i] = bp[(size_t)i * 2560 + 1024]; }
    }
    {
      u32x4 a, b2;
#pragma unroll
      for (int i = 0; i < 4; ++i) { a[i] = (unsigned)rv_[2 * i] | ((unsigned)rv_[2 * i + 1] << 16); b2[i] = (unsigned)rv_[8 + 2 * i] | ((unsigned)rv_[8 + 2 * i + 1] << 16); }
      *(u32x4*)(Vt + cch * TP + 16 * seg) = a; *(u32x4*)(Vt + cch * TP + 16 * seg + 8) = b2;
    }
    f32x16 oacc = zero16();
    float qs[16];
#pragma unroll
    for (int i = 0; i < 16; ++i) qs[i] = silu_f(bf2f(rq_[i]));
#pragma unroll
    for (int dir = 0; dir < 2; ++dir) {
      const int c = hg_chunk_of_block(dir, tb);
      const int chain = (b * 2 + dir) * 4 + head;
      const bf16_t* Sc = U + ((size_t)chain * NCHUNK + c) * 16384 + (size_t)(dvt * 32 + (lane & 31)) * 128 + 8 * h;
      bf16x8 sf[8];
#pragma unroll
      for (int ks = 0; ks < 8; ++ks) sf[ks] = *(const bf16x8*)(Sc + ks * 16);
      float kk[16], bl[16];
      const float lbv = LB[layer * 1024 + dir * 512 + head * 128 + cch];
      const float tot = dir == 0 ? hg_gates_raw(rf0_, lbv, 0, kk, bl) : hg_gates_raw(rf1_, lbv, 1, kk, bl);
      segt[seg * 128 + cch] = tot;
      __syncthreads();
      const float t0 = segt[cch], t1 = segt[128 + cch], t2 = segt[256 + cch], t3 = segt[384 + cch];
      float ref[4];
      if (dir == 0) { ref[0] = 0.f; ref[1] = t0; ref[2] = t0 + t1; ref[3] = t0 + t1 + t2; }
      else { ref[3] = 0.f; ref[2] = t3; ref[1] = t3 + t2; ref[0] = t3 + t2 + t1; }
      float pre = seg == 0 ? ref[0] : (seg == 1 ? ref[1] : (seg == 2 ? ref[2] : ref[3]));
#pragma unroll
      for (int i = 0; i < 16; ++i) {
        const int t = 16 * seg + i;
        const float bt = pre + bl[i];
        Qe[t * HP + cch] = f2bf(qs[i] * __expf(bt));
        Qr[t * HP + cch] = f2bf(qs[i] * __expf(bl[i]));
#pragma unroll
        for (int I = 0; I < 4; ++I) {
          const bool need = dir == 0 ? (I >= seg) : (I <= seg);
          if (need) Kr[(I * 64 + t) * HP + cch] = f2bf(kk[i] * __expf(fminf(ref[I] - bt, 60.f)));
        }
      }
      __syncthreads();
#pragma unroll
      for (int k2 = 0; k2 < 2; ++k2) {
        const int blk = wave * 2 + k2, I = blk >> 2, J = blk & 3;
        const bool valid = dir == 0 ? (J <= I) : (J >= I);
        f32x4 a4 = {0.f, 0.f, 0.f, 0.f};
        if (valid) {
#pragma unroll
          for (int ks = 0; ks < 4; ++ks) {
            const bf16x8 af = *(const bf16x8*)(Kr + (I * 64 + J * 16 + (lane & 15)) * HP + ks * 32 + 8 * (lane >> 4));
            const bf16x8 bfr = *(const bf16x8*)(Qr + (I * 16 + (lane & 15)) * HP + ks * 32 + 8 * (lane >> 4));
            a4 = MFMA16(af, bfr, a4);
          }
          if (I == J) {
            const int il = lane & 15;
#pragma unroll
            for (int r = 0; r < 4; ++r) { const int jl = 4 * (lane >> 4) + r; const bool ok = dir == 0 ? (jl <= il) : (jl >= il); a4[r] = ok ? a4[r] : 0.f; }
          }
        }
        u32x2 o; o[0] = pk2(a4[0], a4[1]); o[1] = pk2(a4[2], a4[3]);
        *(u32x2*)(Att + (I * 16 + (lane & 15)) * TP + J * 16 + 4 * (lane >> 4)) = o;
      }
      __syncthreads();
#pragma unroll
      for (int ks = 0; ks < 4; ++ks) {
        const bf16x8 af = *(const bf16x8*)(Vt + (dvt * 32 + (lane & 31)) * TP + ks * 16 + 8 * h);
        const bf16x8 bfr = *(const bf16x8*)(Att + (it * 32 + (lane & 31)) * TP + ks * 16 + 8 * h);
        oacc = MFMA32(af, bfr, oacc);
      }
#pragma unroll
      for (int ks = 0; ks < 8; ++ks) {
        const bf16x8 bfr = *(const bf16x8*)(Qe + (it * 32 + (lane & 31)) * HP + ks * 16 + 8 * h);
        oacc = MFMA32(sf[ks], bfr, oacc);
      }
      __syncthreads();
    }
    float ss = 0.f;
#pragma unroll
    for (int r = 0; r < 16; ++r) ss += oacc[r] * oacc[r];
    ss += __shfl_xor(ss, 32);
    if (h == 0) red[(it * 4 + dvt) * 32 + (lane & 31)] = ss;
    __syncthreads();
    const float tot = red[(it * 4 + 0) * 32 + (lane & 31)] + red[(it * 4 + 1) * 32 + (lane & 31)] + red[(it * 4 + 2) * 32 + (lane & 31)] + red[(it * 4 + 3) * 32 + (lane & 31)];
    const float rs = rsqrtf(tot * (1.f / 128.f) + RMS_EPS);
    const int g = g0 + it * 32 + (lane & 31);
    const float* nw = p.hg_norm + layer * 128;
#pragma unroll
    for (int q = 0; q < 4; ++q) {
      const int dv = dvt * 32 + 8 * q + 4 * h;
      const u32x2 gr = *(const u32x2*)(HG + (size_t)g * 2560 + 2048 + head * 128 + dv);
      const f32x4 w4 = *(const f32x4*)(nw + dv);
      const float y0 = oacc[4 * q] * rs * w4[0] * silu_f(bf_lo(gr[0])), y1 = oacc[4 * q + 1] * rs * w4[1] * silu_f(bf_hi(gr[0]));
      const float y2 = oacc[4 * q + 2] * rs * w4[2] * silu_f(bf_lo(gr[1])), y3 = oacc[4 * q + 3] * rs * w4[3] * silu_f(bf_hi(gr[1]));
      u32x2 o; o[0] = pk2(y0, y1); o[1] = pk2(y2, y3);
      *(u32x2*)(YB + (size_t)g * 512 + head * 128 + dv) = o;
    }
    __syncthreads();
  }
}


namespace pg8 {
constexpr int BM = 256, BK = 64, HALF = 128, HTB = HALF * BK * 2, STAGE_BYTES = 8 * HTB, NXCD = 8, WGM = 8;
DI int lds_byte(int r, int c) { const int st = (r >> 4) * 2 + (c >> 5), rr = r & 15, cc = c & 31, ob = rr * 64 + cc * 2; return st * 1024 + (ob ^ (((ob >> 9) & 1) << 5)); }
DI void stage_rc(int b, int& R, int& C) { const int st = b / 1024, sb = b % 1024, swz = sb ^ (((sb >> 9) & 1) << 5); R = (st >> 1) * 16 + swz / 64; C = (st & 1) * 32 + (swz % 64) / 2; }
struct Unit { int pm, pn; const char* A; const char* B; int e, rb, cnt, rowbase; };
typedef f32x4 Acc[2][2][4][2];

DI void static_tile(int L, int nM, int nN, int& pm, int& pn) {
  const int nwg = nM * nN;
  int wgid = L; { const int q = nwg / NXCD, r = nwg % NXCD, xcd = wgid % NXCD, off = wgid / NXCD; wgid = (xcd < r ? xcd * (q + 1) : r * (q + 1) + (xcd - r) * q) + off; }
  const int nig = WGM * nN, gid = wgid / nig, fm = gid * WGM, gsz = (nM - fm) < WGM ? (nM - fm) : WGM;
  pm = fm + ((wgid % nig) % gsz); pn = (wgid % nig) / gsz;
}

template <class Job, bool PROJ>
DI void gemm_phase(LAS unsigned char* lds, const Job& S) {
  const int K = S.K; const bool GATHER = S.gather_rows;
  const int tid = launder_tid(), wid = __builtin_amdgcn_readfirstlane(tid >> 6), lane = tid & 63, wr = wid >> 2, wc = wid & 3, fr = lane & 15, fq = lane >> 4;
  const int nt = K / BK;
  unsigned voffB[2], oA[2][2], o2[2][2];
#pragma unroll
  for (int i = 0; i < 2; ++i) { int R, C; stage_rc(tid * 16 + i * 8192, R, C); voffB[i] = (unsigned)(R * K + C) * 2u; }
  const size_t kstep = (size_t)(BK * 2);
  const size_t hstep = (size_t)HALF * K * 2;
  const unsigned ldsw = (unsigned)wid * 1024u;
  const int aoff = lds_byte(wr * 64 + fr, fq * 8), boff = lds_byte(wc * 32 + fr, fq * 8);
#define PG8_SA(b, h) (((b) * 2 + (h)) * HTB)
#define PG8_SB(b, h) ((4 + (b) * 2 + (h)) * HTB)
#define PG8_STAGE(bufoff, gbase, voff) do { _Pragma("unroll") for (int _i = 0; _i < 2; ++_i) \
    __builtin_amdgcn_global_load_lds((const unsigned*)((const char*)(gbase) + (voff)[_i]), (LAS unsigned*)(lds + (bufoff) + ldsw + _i * 8192), 16, 0, 0); } while (0)
#define PG8_LDA(dst, b, h) do { _Pragma("unroll") for (int m = 0; m < 4; ++m) _Pragma("unroll") for (int k = 0; k < 2; ++k) dst[m][k] = *(const LAS bf16x8*)(lds + PG8_SA(b, h) + aoff + m * 2048 + k * 1024); } while (0)
#define PG8_LDB(dst, b, h) do { _Pragma("unroll") for (int n = 0; n < 2; ++n) _Pragma("unroll") for (int k = 0; k < 2; ++k) dst[n][k] = *(const LAS bf16x8*)(lds + PG8_SB(b, h) + boff + n * 2048 + k * 1024); } while (0)
#define PG8_MMA(ai, bj, At, Bt) do { __builtin_amdgcn_s_setprio(1); _Pragma("unroll") for (int m = 0; m < 4; ++m) _Pragma("unroll") for (int n = 0; n < 2; ++n) _Pragma("unroll") for (int k = 0; k < 2; ++k) \
    acc[ai][bj][m][n] = __builtin_amdgcn_mfma_f32_16x16x32_bf16(Bt[n][k], At[m][k], acc[ai][bj][m][n], 0, 0, 0); __builtin_amdgcn_s_setprio(0); } while (0)
#define PG8_WAIT_V(n) asm volatile("s_waitcnt vmcnt(" #n ")" ::: "memory")
#define PG8_WAIT_L(n) asm volatile("s_waitcnt lgkmcnt(" #n ")" ::: "memory")
#define PG8_BAR __builtin_amdgcn_s_barrier()
#define PG8_SCHED __builtin_amdgcn_sched_barrier(0)
  Unit cur, nxt; int ui = 0;
  if (!S.next(0, cur)) return;
  if (GATHER) S.gather(cur, oA);
  else {
#pragma unroll
    for (int h = 0; h < 2; ++h)
#pragma unroll
      for (int i = 0; i < 2; ++i) oA[h][i] = voffB[i] + (unsigned)(h * HALF * K) * 2u;
  }
  Acc acc;
#pragma unroll
  for (int a = 0; a < 2; ++a)
#pragma unroll
    for (int b = 0; b < 2; ++b)
#pragma unroll
      for (int m = 0; m < 4; ++m)
#pragma unroll
        for (int n = 0; n < 2; ++n) acc[a][b][m][n] = (f32x4){0.f, 0.f, 0.f, 0.f};
  bf16x8 At[4][2], B0[2][2], B1[2][2];
  const char* cA = cur.A; const char* cB = cur.B;
  PG8_STAGE(PG8_SB(0, 0), cB, voffB); PG8_STAGE(PG8_SB(0, 1), cB + hstep, voffB); PG8_STAGE(PG8_SA(0, 0), cA, oA[0]); PG8_STAGE(PG8_SA(0, 1), cA, oA[1]);
  if (wr == 1) PG8_BAR;
  PG8_WAIT_V(2); PG8_BAR;
  PG8_STAGE(PG8_SB(1, 0), cB + kstep, voffB); PG8_STAGE(PG8_SA(1, 0), cA + kstep, oA[0]); PG8_STAGE(PG8_SB(1, 1), cB + hstep + kstep, voffB);
  PG8_WAIT_V(6); PG8_BAR;
  for (;;) {
    const bool has_next = S.next(ui + 1, nxt);
    const char* nA = has_next ? nxt.A : cA; const char* nB = has_next ? nxt.B : cB;
    for (int t = 0; t < nt; t += 2) {
      const bool last = (t == nt - 2);
      const char* a1 = cA + (size_t)(t + 1) * kstep;
      const char* a2 = last ? nA : cA + (size_t)(t + 2) * kstep; const char* b2 = last ? nB : cB + (size_t)(t + 2) * kstep;
      const char* a3 = a2 + kstep; const char* b3 = b2 + kstep;
      if (GATHER && last && has_next) S.gather(nxt, o2);
      else {
#pragma unroll
        for (int h = 0; h < 2; ++h)
#pragma unroll
          for (int i = 0; i < 2; ++i) o2[h][i] = oA[h][i];
      }
      PG8_LDB(B0, 0, 0); PG8_LDB(B1, 0, 1); PG8_SCHED; PG8_LDA(At, 0, 0); PG8_STAGE(PG8_SA(1, 1), a1, oA[1]);
      PG8_WAIT_V(8); PG8_WAIT_L(0); PG8_BAR; PG8_MMA(0, 0, At, B0); PG8_MMA(0, 1, At, B1); PG8_BAR; PG8_SCHED;
      PG8_LDA(At, 0, 1); PG8_STAGE(PG8_SB(0, 0), b2, voffB); PG8_STAGE(PG8_SB(0, 1), b2 + hstep, voffB); PG8_STAGE(PG8_SA(0, 0), a2, o2[0]);
      PG8_WAIT_V(8); PG8_WAIT_L(0); PG8_BAR; PG8_MMA(1, 0, At, B0); PG8_MMA(1, 1, At, B1); PG8_BAR; PG8_SCHED;
      PG8_LDB(B0, 1, 0); PG8_LDB(B1, 1, 1); PG8_SCHED; PG8_LDA(At, 1, 0); PG8_STAGE(PG8_SA(0, 1), a2, o2[1]);
      PG8_WAIT_V(8); PG8_WAIT_L(0); PG8_BAR; PG8_MMA(0, 0, At, B0); PG8_MMA(0, 1, At, B1); PG8_BAR; PG8_SCHED;
      PG8_LDA(At, 1, 1); PG8_STAGE(PG8_SB(1, 0), b3, voffB); PG8_STAGE(PG8_SB(1, 1), b3 + hstep, voffB); PG8_STAGE(PG8_SA(1, 0), a3, o2[0]);
      PG8_WAIT_V(8); PG8_WAIT_L(0); PG8_BAR; PG8_MMA(1, 0, At, B0); PG8_MMA(1, 1, At, B1); PG8_BAR; PG8_SCHED;
    }
    if (wr == 0) PG8_BAR;
    { int fr_ = fr, fq_ = fq; asm volatile("" : "+v"(fr_), "+v"(fq_));
      if (PROJ) S.epilogue_proj(acc, cur, wr, wc, fr_, fq_); else S.epilogue(acc, cur, wr, wc, fr_, fq_); }
    if (!has_next) break;
    if (!(PROJ && cur.e < 2)) {
#pragma unroll
      for (int a = 0; a < 2; ++a)
#pragma unroll
        for (int b = 0; b < 2; ++b)
#pragma unroll
          for (int m = 0; m < 4; ++m)
#pragma unroll
            for (int n = 0; n < 2; ++n) acc[a][b][m][n] = (f32x4){0.f, 0.f, 0.f, 0.f};
    }
    cur = nxt; cA = nA; cB = nB; ++ui;
    if (GATHER) {
#pragma unroll
      for (int h = 0; h < 2; ++h)
#pragma unroll
        for (int i = 0; i < 2; ++i) oA[h][i] = o2[h][i];
    }
    if (wr == 1) PG8_BAR;
  }
  PG8_WAIT_V(0);
  PG8_BAR;
#undef PG8_SA
#undef PG8_SB
#undef PG8_STAGE
#undef PG8_LDA
#undef PG8_LDB
#undef PG8_MMA
#undef PG8_WAIT_V
#undef PG8_WAIT_L
#undef PG8_BAR
#undef PG8_SCHED
}
}
constexpr int C3_MAXTOK = 272;
__device__ void phase_c3(const Params& p, int layer, unsigned char* smem) {
  const int tid = launder_tid(), lane = tid & 63, wave = tid >> 6;
  float* wr = (float*)smem;
  int* lcount = (int*)(smem + 65536);
  int* lbase = lcount + 16;
  int* tok_e = lbase + 16;
  int* tok_pos = tok_e + 2 * C3_MAXTOK;
  for (int i = tid; i < 16 * 1024; i += NTHREADS) { const int col = i >> 4, e = i & 15; wr[e * 1024 + col] = p.w_router[i]; }
  if (tid < 16) lcount[tid] = 0;
  __syncthreads();
  const float* nw = p.norm2 + layer * D;
  bf16_t* HX = (bf16_t*)(p.ws + WS_HX);
  float* WTS = (float*)(p.ws + WS_WTS);
  int* LIST = (int*)(p.ws + WS_LIST);
  int* CNT = (int*)(p.ws + WS_CNT) + layer * 16;
  int li = wave;
  for (int g = blockIdx.x * 8 + wave; g < NTOK; g += gridDim.x * 8, li += 8) {
    if (layer == 1 && (g % NT) < L) continue;
    const float* src = res_in_row(p, 1, g);
    const int v = mod_vec(g);
    f32x4 x[4];
#pragma unroll
    for (int i = 0; i < 4; ++i) x[i] = *(const f32x4*)(src + (i * 64 + lane) * 4);
    float ss = 0.f;
#pragma unroll
    for (int i = 0; i < 4; ++i) ss += x[i][0] * x[i][0] + x[i][1] * x[i][1] + x[i][2] * x[i][2] + x[i][3] * x[i][3];
    ss = wave_sum(ss);
    const float r = rsqrtf(ss * (1.f / D) + RMS_EPS);
    const float* sh = mod_ptr(p, layer, v, 3);
    const float* scl = mod_ptr(p, layer, v, 4);
    float lg[16];
#pragma unroll
    for (int e = 0; e < 16; ++e) lg[e] = 0.f;
#pragma unroll
    for (int i = 0; i < 4; ++i) {
      const int col = (i * 64 + lane) * 4;
      const f32x4 w4 = *(const f32x4*)(nw + col), s4 = *(const f32x4*)(sh + col), c4 = *(const f32x4*)(scl + col);
      float y[4];
#pragma unroll
      for (int k = 0; k < 4; ++k) y[k] = x[i][k] * r * w4[k] * (1.f + c4[k]) + s4[k];
      u32x2 o; o[0] = pk2(y[0], y[1]); o[1] = pk2(y[2], y[3]);
      *(u32x2*)(HX + (size_t)g * D + col) = o;
#pragma unroll
      for (int e = 0; e < 16; ++e) {
        const f32x4 wv = *(const f32x4*)(wr + e * 1024 + col);
        lg[e] += y[0] * wv[0] + y[1] * wv[1] + y[2] * wv[2] + y[3] * wv[3];
      }
    }
#pragma unroll
    for (int e = 0; e < 16; ++e) lg[e] = wave_sum(lg[e]);
    float mx = lg[0];
#pragma unroll
    for (int e = 1; e < 16; ++e) mx = fmaxf(mx, lg[e]);
    float pr[16], den = 0.f;
#pragma unroll
    for (int e = 0; e < 16; ++e) { pr[e] = expf(lg[e] - mx); den += pr[e]; }
    const float inv = 1.f / den;
    float sel[16];
#pragma unroll
    for (int e = 0; e < 16; ++e) { pr[e] *= inv; sel[e] = pr[e] + p.b_router[e]; }
    int bg = 0; float bs = -__builtin_inff();
#pragma unroll
    for (int gi = 0; gi < 4; ++gi) {
      float a = -__builtin_inff(), b2 = -__builtin_inff();
#pragma unroll
      for (int k = 0; k < 4; ++k) { const float s = sel[gi * 4 + k]; if (s > a) { b2 = a; a = s; } else if (s > b2) b2 = s; }
      const float sc = a + b2;
      if (sc > bs) { bs = sc; bg = gi; }
    }
    float sg[4], pg[4];
#pragma unroll
    for (int k = 0; k < 4; ++k) { sg[k] = bg == 0 ? sel[k] : (bg == 1 ? sel[4 + k] : (bg == 2 ? sel[8 + k] : sel[12 + k])); pg[k] = bg == 0 ? pr[k] : (bg == 1 ? pr[4 + k] : (bg == 2 ? pr[8 + k] : pr[12 + k])); }
    int i0 = 0; float s0 = sg[0], p0 = pg[0];
#pragma unroll
    for (int k = 1; k < 4; ++k) if (sg[k] > s0) { s0 = sg[k]; p0 = pg[k]; i0 = k; }
    int i1 = 0; float s1 = -__builtin_inff(), p1 = 0.f;
#pragma unroll
    for (int k = 0; k < 4; ++k) if (k != i0 && sg[k] > s1) { s1 = sg[k]; p1 = pg[k]; i1 = k; }
    const int e0 = bg * 4 + i0, e1 = bg * 4 + i1;
    if (lane == 0) {
      const float wsum = p0 + p1;
      WTS[2 * g] = p0 / wsum; WTS[2 * g + 1] = p1 / wsum;
      tok_e[2 * li] = e0; tok_e[2 * li + 1] = e1;
      tok_pos[2 * li] = atomicAdd(&lcount[e0], 1); tok_pos[2 * li + 1] = atomicAdd(&lcount[e1], 1);
    }
  }
  __syncthreads();
  if (tid < 16) lbase[tid] = atomicAdd(&CNT[tid], lcount[tid]);
  __syncthreads();
  li = wave;
  for (int g = blockIdx.x * 8 + wave; g < NTOK; g += gridDim.x * 8, li += 8) {
    if (layer == 1 && (g % NT) < L) continue;
    if (lane < 2) { const int e = tok_e[2 * li + lane]; LIST[(size_t)e * NTOK + lbase[e] + tok_pos[2 * li + lane]] = 2 * g + lane; }
  }
}

struct MoeUnit { int e, rb, cnt, rowbase; };
DI bool moe_unit(const int* CNT, int rbg, MoeUnit& mu) {
  int acc = 0, rowbase = 0;
  mu.e = 0; mu.rb = 0; mu.cnt = 1; mu.rowbase = 0;
  for (int e = 0; e < 16; ++e) {
    const int c = CNT[e], nb = (c + 255) >> 8;
    if (rbg < acc + nb) { mu.e = e; mu.rb = rbg - acc; mu.cnt = c; mu.rowbase = rowbase; return true; }
    acc += nb; rowbase += nb * 256;
  }
  return false;
}
DI int moe_total_rb(const int* CNT) { int acc = 0; for (int e = 0; e < 16; ++e) acc += (CNT[e] + 255) >> 8; return acc; }


DI int row_tile_map(int pm, bool latent_only) { return latent_only ? (pm < 32 ? pm + 1 : pm + 2) : pm; }
struct DenseSched {
  const char* A; const char* B; int nM, nN, K, G, c; bool latent_only; bool rev_n;
  DI bool next(int i, pg8::Unit& u) const {
    const int Lx = i * G + c; if (Lx >= nM * nN) return false;
    int pm, pn; pg8::static_tile(Lx, nM, nN, pm, pn); pm = row_tile_map(pm, latent_only);
    if (rev_n) pn = nN - 1 - pn;
    u.pm = pm; u.pn = pn; u.A = A + (size_t)pm * 256 * K * 2; u.B = B + (size_t)pn * 256 * K * 2; u.e = 0; return true;
  }
};
struct ProjSched {
  const char* Y; const char* Wp; int nM, G, c; bool latent_only;
  DI bool next(int i, pg8::Unit& u) const {
    const int br = i % 3, Lx = (i / 3) * G + c; if (Lx >= nM * 4) return false;
    int pm, pn; pg8::static_tile(Lx, nM, 4, pm, pn); pm = row_tile_map(pm, latent_only);
    u.pm = pm; u.pn = pn; u.e = br;
    u.A = Y + ((size_t)br * NTOK + (size_t)pm * 256) * 512 * 2; u.B = Wp + ((size_t)br * 1024 + (size_t)pn * 256) * 512 * 2; return true;
  }
};
struct MoeSched {
  const int* desc; const int* LIST; const char* Abase; const char* Wexp; bool gate;
  DI bool next(int i, pg8::Unit& u) const {
    if (i >= 16) return false;
    const int e = __builtin_amdgcn_readfirstlane(desc[i * 8 + 0]); if (e < 0) return false;
    u.pm = i; u.e = e; u.rb = __builtin_amdgcn_readfirstlane(desc[i * 8 + 1]); u.cnt = __builtin_amdgcn_readfirstlane(desc[i * 8 + 2]);
    u.rowbase = __builtin_amdgcn_readfirstlane(desc[i * 8 + 3]); u.pn = __builtin_amdgcn_readfirstlane(desc[i * 8 + 4]);
    const char* we = Wexp + (size_t)e * WE_PER;
    if (gate) { u.A = Abase; u.B = we + (size_t)u.pn * 256 * D * 2; }
    else { u.A = Abase + (size_t)(u.rowbase + u.rb * 256) * 512 * 2; u.B = we + (size_t)1024 * 1024 * 2 + (size_t)u.pn * 256 * 512 * 2; }
    return true;
  }
  DI void gather(const pg8::Unit& u, unsigned (&o)[2][2]) const {
    const int tid = launder_tid(); int RA[2], CA[2];
#pragma unroll
    for (int i = 0; i < 2; ++i) pg8::stage_rc(tid * 16 + i * 8192, RA[i], CA[i]);
    const int* rows = desc + 16 * 8 + u.pm * 256;
#pragma unroll
    for (int h = 0; h < 2; ++h)
#pragma unroll
      for (int i = 0; i < 2; ++i) o[h][i] = (unsigned)(rows[h * 128 + RA[i]] * D + CA[i]) * 2u;
  }
};
DI int* moe_build_desc(const int* CNT, const int* LIST, bool rows_too, unsigned char* smem) {
  int* desc = (int*)(smem + 131072);
  const int tid = launder_tid();
  __syncthreads();
  if (tid < 16) {
    const int Lx = tid * (int)gridDim.x + (int)blockIdx.x;
    MoeUnit mu; const bool ok = moe_unit(CNT, Lx >> 2, mu);
    desc[tid * 8 + 0] = ok ? mu.e : -1; desc[tid * 8 + 1] = mu.rb; desc[tid * 8 + 2] = mu.cnt; desc[tid * 8 + 3] = mu.rowbase; desc[tid * 8 + 4] = Lx & 3;
  }
  __syncthreads();
  if (rows_too) {
    for (int s = 0; s < 3; ++s) {
      const int e = desc[s * 8 + 0];
      if (e >= 0 && tid < 256) {
        const int rb = desc[s * 8 + 1], cnt = desc[s * 8 + 2];
        const int ri = min(rb * 256 + tid, cnt - 1);
        desc[16 * 8 + s * 256 + tid] = LIST[(size_t)e * NTOK + ri] >> 1;
      }
    }
    if (tid == 0 && desc[3 * 8 + 0] >= 0) desc[3 * 8 + 0] = -1;
    __syncthreads();
  }
  return desc;
}

DI void st8bf(bf16_t* dst, const f32x4& a, const f32x4& b) { u32x4 o; o[0] = pk2(a[0], a[1]); o[1] = pk2(a[2], a[3]); o[2] = pk2(b[0], b[1]); o[3] = pk2(b[2], b[3]); *(u32x4*)dst = o; }
DI void st4bf(bf16_t* dst, float a, float b, float c, float d) { u32x2 o; o[0] = pk2(a, b); o[1] = pk2(c, d); *(u32x2*)dst = o; }
DI void quad_transpose(float (&a)[4], int q) {
  const bool o1 = (q & 1) != 0, o2 = (q & 2) != 0;
  const float r0 = __shfl_xor(o1 ? a[0] : a[1], 1), r1 = __shfl_xor(o1 ? a[2] : a[3], 1);
  const float p00 = o1 ? r0 : a[0], p01 = o1 ? a[1] : r0, p10 = o1 ? r1 : a[2], p11 = o1 ? a[3] : r1;
  const float u0 = __shfl_xor(o2 ? p00 : p10, 2), u1 = __shfl_xor(o2 ? p01 : p11, 2);
  a[0] = o2 ? u0 : p00; a[1] = o2 ? u1 : p01; a[2] = o2 ? p10 : u0; a[3] = o2 ? p11 : u1;
}
struct EpiA1 {
  const Params* pp; int layer;
  DI void operator()(const pg8::Acc& acc, const pg8::Unit& u, int wr, int wc, int fr, int fq) const {
    const Params& p = *pp; const int pn = u.pn;
    const float* rope = (const float*)(p.ws + WS_ROPE);
#pragma unroll
    for (int ai = 0; ai < 2; ++ai)
#pragma unroll
      for (int m = 0; m < 4; ++m) {
        const int g = u.pm * 256 + ai * 128 + wr * 64 + m * 16 + fr;
        const int b = g / NT, n = g - b * NT;
        float v[2][2][4];
#pragma unroll
        for (int bj = 0; bj < 2; ++bj)
#pragma unroll
          for (int n2 = 0; n2 < 2; ++n2)
#pragma unroll
            for (int i = 0; i < 4; ++i) v[bj][n2][i] = acc[ai][bj][m][n2][i];
        const bool is_v = (pn == 4 || pn == 5 || (pn == 18 && wc >= 2));
        const bool is_hg = (pn >= 6 && pn < 16);
        if (is_hg) {
          bf16_t* dst = (bf16_t*)(p.ws + WS_HG) + (size_t)g * 2560 + (pn * 256 - 1536) + 64 * wc + 8 * fq;
#pragma unroll
          for (int bj = 0; bj < 2; ++bj) st8bf(dst + 32 * bj, acc[ai][bj][m][0], acc[ai][bj][m][1]);
        } else if (is_v) {
          const int q = fr & 3;
          bf16_t* dst = (pn == 18 ? (bf16_t*)(p.ws + WS_VWT) + ((size_t)(b * 2 + (wc - 2)) * 64) * NT
                                  : (bf16_t*)(p.ws + WS_VAT) + ((size_t)(b * 8 + (pn - 4) * 4 + wc) * 64) * NT) + (n - q);
#pragma unroll
          for (int bj = 0; bj < 2; ++bj)
#pragma unroll
            for (int n2 = 0; n2 < 2; ++n2) {
              quad_transpose(v[bj][n2], q);
              st4bf(dst + (size_t)(32 * bj + 16 * n2 + 4 * fq + q) * NT, v[bj][n2][0], v[bj][n2][1], v[bj][n2][2], v[bj][n2][3]);
            }
        } else {
          const bool wa = pn >= 16;
          const bool isq = (pn < 2) || (pn == 16 || pn == 17);
          float ss = 0.f;
#pragma unroll
          for (int bj = 0; bj < 2; ++bj)
#pragma unroll
            for (int n2 = 0; n2 < 2; ++n2)
#pragma unroll
              for (int i = 0; i < 4; ++i) ss += v[bj][n2][i] * v[bj][n2][i];
          ss += __shfl_xor(ss, 16); ss += __shfl_xor(ss, 32);
          const float rs = rsqrtf(ss * (1.f / 64.f) + RMS_EPS);
          const float* nw = (wa ? (isq ? p.wa_qn : p.wa_kn) : (isq ? p.na_qn : p.na_kn)) + layer * 64;
#pragma unroll
          for (int bj = 0; bj < 2; ++bj)
#pragma unroll
            for (int n2 = 0; n2 < 2; ++n2) {
              const f32x4 w4 = *(const f32x4*)(nw + 32 * bj + 16 * n2 + 4 * fq);
#pragma unroll
              for (int i = 0; i < 4; ++i) v[bj][n2][i] *= rs * w4[i];
            }
          if (wa && n >= L) {
            const int t = n - L;
#pragma unroll
            for (int bj = 0; bj < 2; ++bj) {
              const int pos = bj == 0 ? (t >> 6) : (t & 63);
              const f32x4 cs = *(const f32x4*)(rope + pos * 16 + 4 * fq), sn = *(const f32x4*)(rope + 2048 + pos * 16 + 4 * fq);
#pragma unroll
              for (int i = 0; i < 4; ++i) { const float x1 = v[bj][0][i], x2 = v[bj][1][i]; v[bj][0][i] = x1 * cs[i] - x2 * sn[i]; v[bj][1][i] = x2 * cs[i] + x1 * sn[i]; }
            }
          }
          bf16_t* dst;
          if (pn < 2) dst = (bf16_t*)(p.ws + WS_QA) + (size_t)g * 512 + (pn * 4 + wc) * 64;
          else if (pn < 4) dst = (bf16_t*)(p.ws + WS_KA) + (size_t)g * 512 + ((pn - 2) * 4 + wc) * 64;
          else if (pn < 18) dst = (bf16_t*)(p.ws + WS_QW) + (size_t)g * 512 + ((pn - 16) * 4 + wc) * 64;
          else dst = (bf16_t*)(p.ws + WS_KW) + (size_t)g * 128 + wc * 64;
#pragma unroll
          for (int bj = 0; bj < 2; ++bj)
#pragma unroll
            for (int n2 = 0; n2 < 2; ++n2) st4bf(dst + 32 * bj + 16 * n2 + 4 * fq, v[bj][n2][0], v[bj][n2][1], v[bj][n2][2], v[bj][n2][3]);
        }
      }
  }
};
struct EpiGate {
  bf16_t* G;
  DI void operator()(const pg8::Acc& acc, const pg8::Unit& u, int wr, int wc, int fr, int fq) const {
#pragma unroll
    for (int ai = 0; ai < 2; ++ai)
#pragma unroll
      for (int m = 0; m < 4; ++m) {
        bf16_t* rowp = G + (size_t)(u.pm * 256 + ai * 128 + wr * 64 + m * 16 + fr) * 3072 + u.pn * 256 + 32 * wc + 8 * fq;
#pragma unroll
        for (int bj = 0; bj < 2; ++bj) {
          f32x4 a = acc[ai][bj][m][0], c = acc[ai][bj][m][1];
#pragma unroll
          for (int i = 0; i < 4; ++i) { a[i] = sigmoid_f(a[i]); c[i] = sigmoid_f(c[i]); }
          st8bf(rowp + 128 * bj, a, c);
        }
      }
  }
};
struct EpiProj {
  const bf16_t* G; bf16_t* M;
  DI void operator()(pg8::Acc& acc, const pg8::Unit& u, int wr, int wc, int fr, int fq) const {
    const int br = u.e;
#pragma unroll
    for (int ai = 0; ai < 2; ++ai)
#pragma unroll
      for (int m = 0; m < 4; ++m) {
        const size_t g = (size_t)(u.pm * 256 + ai * 128 + wr * 64 + m * 16 + fr);
        const int col0 = u.pn * 256 + 32 * wc + 8 * fq;
        const bf16_t* gp = G + g * 3072 + br * 1024 + col0;
        asm volatile("" : "+v"(gp) :: "memory");
#pragma unroll
        for (int bj = 0; bj < 2; ++bj) {
          const u32x4 gg = *(const u32x4*)(gp + 128 * bj);
          u32x4 gn = gg;
          if (br < 2) gn = *(const u32x4*)(gp + 1024 + 128 * bj);
#pragma unroll
          for (int hq = 0; hq < 2; ++hq) {
            f32x4 a = acc[ai][bj][m][hq];
#pragma unroll
            for (int e = 0; e < 4; ++e) {
              const unsigned gw = gg[2 * hq + (e >> 1)], nw = gn[2 * hq + (e >> 1)];
              float s = (e & 1) ? bf_hi(gw) : bf_lo(gw);
              if (br > 0) s = fmaxf(s, 1e-6f);
              if (br < 2) s *= __builtin_amdgcn_rcpf(fmaxf((e & 1) ? bf_hi(nw) : bf_lo(nw), 1e-6f));
              a[e] *= s;
            }
            acc[ai][bj][m][hq] = a;
          }
          if (br == 2) st8bf(M + g * D + col0 + 128 * bj, acc[ai][bj][m][0], acc[ai][bj][m][1]);
        }
      }
  }
};
struct EpiOut {
  const Params* pp; int layer;
  DI void operator()(const pg8::Acc& acc, const pg8::Unit& u, int wr, int wc, int fr, int fq) const {
    const Params& p = *pp;
#pragma unroll
    for (int ai = 0; ai < 2; ++ai)
#pragma unroll
      for (int m = 0; m < 4; ++m) {
        const int g = u.pm * 256 + ai * 128 + wr * 64 + m * 16 + fr;
        const float* src = res_in_row(p, layer, g); float* dst = res_out_row(p, g);
        const float* g2 = mod_ptr(p, layer, mod_vec(g), 2);
#pragma unroll
        for (int bj = 0; bj < 2; ++bj)
#pragma unroll
          for (int n = 0; n < 2; ++n) {
            const int col = u.pn * 256 + 128 * bj + 32 * wc + 16 * n + 4 * fq;
            const f32x4 xr = *(const f32x4*)(src + col), gg = *(const f32x4*)(g2 + col), a = acc[ai][bj][m][n];
            f32x4 o; o[0] = xr[0] + gg[0] * a[0]; o[1] = xr[1] + gg[1] * a[1]; o[2] = xr[2] + gg[2] * a[2]; o[3] = xr[3] + gg[3] * a[3];
            *(f32x4*)(dst + col) = o;
          }
      }
  }
};
struct EpiAct {
  bf16_t* ACT;
  DI void operator()(const pg8::Acc& acc, const pg8::Unit& u, int wr, int wc, int fr, int fq) const {
#pragma unroll
    for (int ai = 0; ai < 2; ++ai)
#pragma unroll
      for (int m = 0; m < 4; ++m) {
        const int rl = u.rb * 256 + ai * 128 + wr * 64 + m * 16 + fr;
        if (rl < u.cnt) {
          bf16_t* rowp = ACT + (size_t)(u.rowbase + rl) * 512 + u.pn * 128 + 32 * wc + 8 * fq;
          f32x4 a, c;
#pragma unroll
          for (int i = 0; i < 4; ++i) { a[i] = silu_f(acc[ai][0][m][0][i]) * acc[ai][1][m][0][i]; c[i] = silu_f(acc[ai][0][m][1][i]) * acc[ai][1][m][1][i]; }
          st8bf(rowp, a, c);
        }
      }
  }
};
struct EpiDown {
  bf16_t* YS; const float* WTS; const int* LIST;
  DI void operator()(const pg8::Acc& acc, const pg8::Unit& u, int wr, int wc, int fr, int fq) const {
#pragma unroll
    for (int ai = 0; ai < 2; ++ai)
#pragma unroll
      for (int m = 0; m < 4; ++m) {
        const int rl = u.rb * 256 + ai * 128 + wr * 64 + m * 16 + fr;
        if (rl < u.cnt) {
          const int aid = LIST[(size_t)u.e * NTOK + rl];
          const float w = WTS[aid];
          bf16_t* rowp = YS + (size_t)aid * D + u.pn * 256 + 32 * wc + 8 * fq;
#pragma unroll
          for (int bj = 0; bj < 2; ++bj) { const f32x4 a = acc[ai][bj][m][0] * w, c = acc[ai][bj][m][1] * w; st8bf(rowp + 128 * bj, a, c); }
        }
      }
  }
};


enum { GK_A1 = 0, GK_GATES = 1, GK_PROJ = 2, GK_OUT = 3, GK_ACT = 4, GK_DOWN = 5 };
struct GemmJob {
  int gk, K; bool gather_rows, latent_only; int nM, nN, G, c, layer;
  const char* A; const char* B; const int* desc; const Params* pp;
  DI bool next(int i, pg8::Unit& u) const {
    if (gk >= GK_ACT) {
      MoeSched S{desc, (const int*)(pp->ws + WS_LIST), A, B, gk == GK_ACT};
      return S.next(i, u);
    }
    if (gk == GK_PROJ) { ProjSched S{A, B, nM, G, c, latent_only}; return S.next(i, u); }
    DenseSched S{A, B, nM, nN, K, G, c, latent_only, gk == GK_A1};
    return S.next(i, u);
  }
  DI void gather(const pg8::Unit& u, unsigned (&o)[2][2]) const {
    MoeSched S{desc, (const int*)(pp->ws + WS_LIST), A, B, true};
    S.gather(u, o);
  }
  DI void epilogue_proj(pg8::Acc& acc, const pg8::Unit& u, int wr, int wc, int fr, int fq) const {
    const Params& p = *pp;
    const bf16_t* Gsrc = (const bf16_t*)(p.ws + WS_G); EpiProj E{Gsrc, (bf16_t*)(p.ws + WS_MERGED)}; E(acc, u, wr, wc, fr, fq);
  }
  DI void epilogue(const pg8::Acc& acc, const pg8::Unit& u, int wr, int wc, int fr, int fq) const {
    const Params& p = *pp;
    switch (gk) {
      case GK_A1: { EpiA1 E{pp, layer}; E(acc, u, wr, wc, fr, fq); break; }
      case GK_GATES: { EpiGate E{(bf16_t*)(p.ws + WS_G)}; E(acc, u, wr, wc, fr, fq); break; }
      case GK_OUT: { EpiOut E{pp, layer}; E(acc, u, wr, wc, fr, fq); break; }
      case GK_ACT: { EpiAct E{(bf16_t*)(p.ws + WS_ACT)}; E(acc, u, wr, wc, fr, fq); break; }
      default: { EpiDown E{(bf16_t*)(p.ws + WS_YS), (const float*)(p.ws + WS_WTS), (const int*)(p.ws + WS_LIST)}; E(acc, u, wr, wc, fr, fq); break; }
    }
  }
};
DI GemmJob make_job(const Params& p, int gk, int layer, unsigned char* smem) {
  GemmJob j{}; j.gk = gk; j.layer = layer; j.pp = &p; j.G = (int)gridDim.x; j.c = (int)blockIdx.x; j.latent_only = false; j.gather_rows = false; j.desc = nullptr; j.nM = NTOK / 256; j.nN = 4; j.K = D;
  const bool lo = layer == 1;
  const char* wm = (const char*)(p.ws + WS_WMIX);
  switch (gk) {
    case GK_A1: j.A = (const char*)(p.ws + WS_H); j.B = wm + WM_WIN; j.nN = PCOLS / 256; break;
    case GK_GATES: j.A = (const char*)(p.ws + WS_H); j.B = wm + WM_WG; j.nN = 12; j.latent_only = lo; j.nM = lo ? 64 : 66; break;
    case GK_PROJ: j.A = (const char*)(p.ws + WS_Y); j.B = wm + WM_WP; j.K = 512; j.latent_only = lo; j.nM = lo ? 64 : 66; break;
    case GK_OUT: j.A = (const char*)(p.ws + WS_MERGED); j.B = wm + WM_WO; j.latent_only = lo; j.nM = lo ? 64 : 66; break;
    case GK_ACT: j.A = (const char*)(p.ws + WS_HX); j.B = (const char*)(p.ws + WS_WEXP); j.gather_rows = true; j.desc = moe_build_desc((const int*)(p.ws + WS_CNT) + layer * 16, (const int*)(p.ws + WS_LIST), true, smem); break;
    default: j.A = (const char*)(p.ws + WS_ACT); j.B = (const char*)(p.ws + WS_WEXP); j.K = 512; j.desc = moe_build_desc((const int*)(p.ws + WS_CNT) + layer * 16, (const int*)(p.ws + WS_LIST), false, smem); break;
  }
  return j;
}
__device__ void phase_final(const Params& p) {
  const int tid_ = launder_tid(), lane = tid_ & 63, wave = tid_ >> 6;
  const bf16_t* YS = (const bf16_t*)(p.ws + WS_YS);
  for (int r = blockIdx.x * 8 + wave; r < NB * T; r += gridDim.x * 8) {
    const int b = r / T, t = r - b * T, g = b * NT + L + t;
    float* row = p.out + (size_t)r * D;
    const float* g5 = mod_ptr(p, 1, b, 5);
#pragma unroll
    for (int i = 0; i < 4; ++i) {
      const int col = (i * 64 + lane) * 4;
      f32x4 x = *(const f32x4*)(row + col);
      const u32x2 y0 = *(const u32x2*)(YS + (size_t)(2 * g) * D + col), y1 = *(const u32x2*)(YS + (size_t)(2 * g + 1) * D + col);
      const f32x4 gg = *(const f32x4*)(g5 + col);
      x[0] += gg[0] * (bf_lo(y0[0]) + bf_lo(y1[0])); x[1] += gg[1] * (bf_hi(y0[0]) + bf_hi(y1[0]));
      x[2] += gg[2] * (bf_lo(y0[1]) + bf_lo(y1[1])); x[3] += gg[3] * (bf_hi(y0[1]) + bf_hi(y1[1]));
      *(f32x4*)(row + col) = x;
    }
  }
}

__global__ void __launch_bounds__(NTHREADS, 2) mk_forward(Params p) {
  extern __shared__ __attribute__((aligned(16))) unsigned char smem[];
  volatile LAS unsigned* bst = (volatile LAS unsigned*)((LAS unsigned char*)smem + LDS_BYTES);
  if (threadIdx.x < 4) bst[threadIdx.x] = 0u;
  __syncthreads();
  const XcdBarrier gbar = xcd_barrier_post((unsigned*)(p.ws + WS_CTL), bst);
  phase_p0(p, smem);
  __syncthreads();
  conv_mixer(p, 0, smem);
  xcd_barrier(gbar);
#pragma unroll 1
  for (int step = 0; step < 22; ++step) {
    const int layer = step >= 11 ? 1 : 0, k = step - layer * 11;
    int gk = -1;
    switch (k) {
      case 0: phase_a0(p, layer); break;
      case 1: gk = GK_A1; break;
      case 2: phase_hg_b1(p, layer, smem); phase_attn(p, layer, smem); break;
      case 3: phase_hg_b2(p, layer, smem); break;
      case 4: phase_hg_b3(p, layer, smem); break;
      case 5: gk = GK_GATES; break;
      case 6: gk = GK_PROJ; break;
      case 7: gk = GK_OUT; break;
      case 8: phase_c3(p, layer, smem); if (layer == 0) { __syncthreads(); conv_mixer(p, 1, smem); } break;
      case 9: gk = GK_ACT; break;
      default: gk = GK_DOWN; break;
    }
    if (gk >= 0) {
      const GemmJob job = make_job(p, gk, layer, smem);
      if (gk == GK_PROJ) pg8::gemm_phase<GemmJob, true>((LAS unsigned char*)smem, job); else pg8::gemm_phase<GemmJob, false>((LAS unsigned char*)smem, job);
    }
    xcd_barrier(gbar);
  }
  phase_final(p);
}

extern "C" void kernel_launch(void* const* d_in, const int* in_sizes, int n_in, void* d_out, int out_size, void* d_ws, size_t ws_size,
                              hipStream_t stream) {
  static int grid_blocks = 0;
  if (!grid_blocks) {
    int dev = 0, cus = 0, per_cu = 0;
    (void)hipGetDevice(&dev);
    (void)hipDeviceGetAttribute(&cus, hipDeviceAttributeMultiprocessorCount, dev);
    (void)hipFuncSetAttribute((const void*)mk_forward, hipFuncAttributeMaxDynamicSharedMemorySize, LDS_BYTES + 16);
    (void)hipOccupancyMaxActiveBlocksPerMultiprocessor(&per_cu, (const void*)mk_forward, NTHREADS, LDS_BYTES + 16);
    if (per_cu < 1) { fprintf(stderr, "kernel_launch: occupancy query reports %d blocks per CU\n", per_cu); per_cu = 1; }
    grid_blocks = cus;
    if (ws_size < WS_TOTAL) fprintf(stderr, "kernel_launch: workspace too small: %zu < %zu\n", ws_size, (size_t)WS_TOTAL);
  }
  Params p{};
  const float* const* in = (const float* const*)d_in;
  p.x = in[0]; p.c = in[1]; p.ctx = in[2]; p.c_ctx = in[3]; p.w_ada = in[4]; p.b_ada = in[5]; p.norm1 = in[6]; p.norm2 = in[7]; p.w_in = in[8];
  p.na_qn = in[9]; p.na_kn = in[10]; p.na_rpb = in[11]; p.hg_lower = in[12]; p.hg_norm = in[13]; p.wa_qn = in[14]; p.wa_kn = in[15]; p.wa_sink = in[16];
  p.w_pa = in[17]; p.w_pb = in[18]; p.w_pc = in[19]; p.w_out = in[20]; p.w_router = in[21]; p.b_router = in[22]; p.w_gate = in[23]; p.w_up = in[24]; p.w_down = in[25];
  p.out = (float*)d_out; p.ws = (unsigned char*)d_ws;
  (void)hipMemsetAsync((char*)d_ws + WS_CTL, 0, CTL_BYTES, stream);
  void* args[] = {&p};
  hipError_t e = hipLaunchCooperativeKernel((const void*)mk_forward, dim3(grid_blocks), dim3(NTHREADS), args, LDS_BYTES + 16, stream);
  if (e != hipSuccess) fprintf(stderr, "cooperative launch failed: %s (grid %d)\n", hipGetErrorString(e), grid_blocks);
}
```

```cpp
#include <hip/hip_runtime.h>
#include <cstdio>
#include <cstdint>

#define DI __device__ __forceinline__
typedef unsigned short bf16_t;
typedef short bf16x8 __attribute__((ext_vector_type(8)));
typedef short s16x4 __attribute__((ext_vector_type(4)));
typedef float f32x2 __attribute__((ext_vector_type(2)));
typedef float f32x4 __attribute__((ext_vector_type(4)));
typedef float f32x16 __attribute__((ext_vector_type(16)));
typedef unsigned u32x2 __attribute__((ext_vector_type(2)));
typedef unsigned u32x4 __attribute__((ext_vector_type(4)));
typedef __bf16 bf16x2_t __attribute__((ext_vector_type(2)));

constexpr int NB = 2, T = 8192, L = 256, NT = L + T, NTOK = NB * NT, D = 1024;
constexpr int INC = 7936;
constexpr int PCOLS = 4864;
constexpr int NCHUNK = NT / 64;
constexpr int NCHAIN = 16;
constexpr int NASSIGN = NTOK * 2;
constexpr float RMS_EPS = 1e-6f;
constexpr float LOG2E = 1.4426950408889634f;
constexpr int NTHREADS = 512;
constexpr int LDS_BYTES = 135168;

constexpr size_t al256(size_t x) { return (x + 255) & ~(size_t)255; }
constexpr size_t WS_CTL = 0;
constexpr size_t CTL_BYTES = 16384;
constexpr size_t WS_MOD = CTL_BYTES;
constexpr size_t WS_ROPE = al256(WS_MOD + 2 * 3 * 6144 * 4);
constexpr size_t WS_LB = al256(WS_ROPE + 2 * 128 * 16 * 4);
constexpr size_t WS_CNT = WS_CTL + 3456 * 4;
constexpr size_t WS_CTXR = al256(WS_LB + 2 * 2 * 512 * 4);
constexpr size_t WS_LIST = al256(WS_CTXR + (size_t)NB * L * D * 4);
constexpr size_t WS_WTS = al256(WS_LIST + (size_t)16 * NTOK * 4);
constexpr size_t WS_DEC = al256(WS_WTS + (size_t)NASSIGN * 4);
constexpr size_t WS_H = al256(WS_DEC + (size_t)NCHAIN * NCHUNK * 128 * 4);
constexpr size_t WS_Y = al256(WS_H + (size_t)NTOK * D * 2);
constexpr size_t WS_U = al256(WS_Y + (size_t)3 * NTOK * 512 * 2);
constexpr size_t WMIX_BYTES = (size_t)(PCOLS + 3072 + 1024) * D * 2 + (size_t)3 * 1024 * 512 * 2;
constexpr size_t WEXP_BYTES = (size_t)16 * (1024 * 1024 + 1024 * 512) * 2;
constexpr size_t WS_WMIX = al256(WS_U + (size_t)NCHAIN * NCHUNK * 16384 * 2);
constexpr size_t WS_WEXP = al256(WS_WMIX + WMIX_BYTES);
constexpr size_t WS_P = al256(WS_WEXP + WEXP_BYTES);
constexpr size_t WS_QA = WS_P;
constexpr size_t WS_KA = al256(WS_QA + (size_t)NTOK * 512 * 2);
constexpr size_t WS_VAT = al256(WS_KA + (size_t)NTOK * 512 * 2);
constexpr size_t WS_HG = al256(WS_VAT + (size_t)NTOK * 512 * 2);
constexpr size_t WS_QW = al256(WS_HG + (size_t)NTOK * 2560 * 2);
constexpr size_t WS_KW = al256(WS_QW + (size_t)NTOK * 512 * 2);
constexpr size_t WS_VWT = al256(WS_KW + (size_t)NTOK * 128 * 2);
constexpr size_t WS_PEND = al256(WS_VWT + (size_t)NTOK * 128 * 2);
constexpr size_t WS_G = WS_P;
constexpr size_t WS_MERGED = al256(WS_G + (size_t)NTOK * 3072 * 2);
constexpr size_t WS_MEND = al256(WS_MERGED + (size_t)NTOK * D * 2);
constexpr size_t WS_HX = WS_P;
constexpr size_t WS_ACT = al256(WS_HX + (size_t)NTOK * D * 2);
constexpr size_t WS_ACTEND = al256(WS_ACT + (size_t)(NASSIGN + 16 * 256) * 512 * 2);
static_assert(WS_MEND <= WS_PEND && WS_ACTEND <= WS_PEND, "P overlays");
constexpr size_t WS_YS = WS_U;
constexpr size_t WS_HGX = WS_PEND;
constexpr size_t WS_TOTAL = al256(WS_HGX + (size_t)512 * 2560 * 2);
static_assert(WS_TOTAL < 400ull * 1000 * 1000, "workspace too large");
static_assert((size_t)NASSIGN * 1024 * 2 <= (size_t)NCHAIN * NCHUNK * 16384 * 2, "YS overlay");

struct Params {
  const float *x, *c, *ctx, *c_ctx, *w_ada, *b_ada, *norm1, *norm2, *w_in, *na_qn, *na_kn, *na_rpb, *hg_lower, *hg_norm,
      *wa_qn, *wa_kn, *wa_sink, *w_pa, *w_pb, *w_pc, *w_out, *w_router, *b_router, *w_gate, *w_up, *w_down;
  float* out;
  unsigned char* ws;
};

DI unsigned pk2(float lo, float hi) { f32x2 v = {lo, hi}; bf16x2_t r = __builtin_convertvector(v, bf16x2_t); return __builtin_bit_cast(unsigned, r); }
DI float bf_lo(unsigned u) { return __uint_as_float(u << 16); }
DI float bf_hi(unsigned u) { return __uint_as_float(u & 0xffff0000u); }
DI float bf2f(bf16_t h) { return __uint_as_float(((unsigned)h) << 16); }
DI bf16_t f2bf(float x) { return (bf16_t)(pk2(x, 0.f) & 0xffffu); }
DI int launder_tid() { int t = threadIdx.x; asm volatile("" : "+v"(t)); return t; }
DI int crow(int reg, int h) { return (reg & 3) + 8 * (reg >> 2) + 4 * h; }
DI float wave_sum(float v) {
  v += __builtin_bit_cast(float, __builtin_amdgcn_update_dpp(0, __builtin_bit_cast(int, v), 0xB1, 0xf, 0xf, true));
  v += __builtin_bit_cast(float, __builtin_amdgcn_update_dpp(0, __builtin_bit_cast(int, v), 0x4E, 0xf, 0xf, true));
  v += __builtin_bit_cast(float, __builtin_amdgcn_update_dpp(0, __builtin_bit_cast(int, v), 0x141, 0xf, 0xf, true));
  v += __builtin_bit_cast(float, __builtin_amdgcn_update_dpp(0, __builtin_bit_cast(int, v), 0x140, 0xf, 0xf, true));
  v += __builtin_bit_cast(float, __builtin_amdgcn_update_dpp(0, __builtin_bit_cast(int, v), 0x142, 0xa, 0xf, false));
  v += __builtin_bit_cast(float, __builtin_amdgcn_update_dpp(0, __builtin_bit_cast(int, v), 0x143, 0xc, 0xf, false));
  return __builtin_bit_cast(float, __builtin_amdgcn_readlane(__builtin_bit_cast(int, v), 63));
}
DI float shfl_x1(float v) { return __builtin_bit_cast(float, __builtin_amdgcn_update_dpp(0, __builtin_bit_cast(int, v), 0xB1, 0xf, 0xf, true)); }
DI float shfl_x2(float v) { return __builtin_bit_cast(float, __builtin_amdgcn_update_dpp(0, __builtin_bit_cast(int, v), 0x4E, 0xf, 0xf, true)); }
DI float sum_x16(float v) { const u32x2 r = __builtin_amdgcn_permlane16_swap(__builtin_bit_cast(unsigned, v), __builtin_bit_cast(unsigned, v), false, false); return __builtin_bit_cast(float, r[0]) + __builtin_bit_cast(float, r[1]); }
DI float sum_x32(float v) { const u32x2 r = __builtin_amdgcn_permlane32_swap(__builtin_bit_cast(unsigned, v), __builtin_bit_cast(unsigned, v), false, false); return __builtin_bit_cast(float, r[0]) + __builtin_bit_cast(float, r[1]); }
DI float max_x32(float v) { const u32x2 r = __builtin_amdgcn_permlane32_swap(__builtin_bit_cast(unsigned, v), __builtin_bit_cast(unsigned, v), false, false); return fmaxf(__builtin_bit_cast(float, r[0]), __builtin_bit_cast(float, r[1])); }
DI float silu_f(float x) { return x / (1.f + __expf(-x)); }
DI float sigmoid_f(float x) { return 1.f / (1.f + __expf(-x)); }
DI f32x16 zero16() { f32x16 z; for (int i = 0; i < 16; ++i) z[i] = 0.f; return z; }
#define MFMA32(a, b, c) __builtin_amdgcn_mfma_f32_32x32x16_bf16((a), (b), (c), 0, 0, 0)
#define MFMA16(a, b, c) __builtin_amdgcn_mfma_f32_16x16x32_bf16((a), (b), (c), 0, 0, 0)


#define LAS __attribute__((address_space(3)))
#define XB_TMO      128
#define XB_XCNT(j)  (256  + 64 * (j))
#define XB_XSUB(j)  (1280 + 64 * (j))
#define XB_XGEN(j)  (2304 + 64 * (j))
#define XB_TOP      3328
#define XB_TOPGEN   3392
#define XCD_BAR_WORDS 3456
#define XB_SPIN_CAP (1u << 18)
DI unsigned xb_ld(unsigned* p) { return __hip_atomic_load(p, __ATOMIC_RELAXED, __HIP_MEMORY_SCOPE_AGENT); }
DI unsigned xb_add(unsigned* p, unsigned v) { return __hip_atomic_fetch_add(p, v, __ATOMIC_RELAXED, __HIP_MEMORY_SCOPE_AGENT); }
DI unsigned xb_xcc_id() { return (unsigned)__builtin_amdgcn_s_getreg((3 << 11) | 20) & 0xFu; }
#define XB_SPIN(cond, bar) do { unsigned _sp = 0; while (cond) { __builtin_amdgcn_s_sleep(1); \
    if ((++_sp & 255u) == 0u) { if (xb_ld(&(bar)[XB_TMO])) break; if (_sp > XB_SPIN_CAP) { atomicAdd(&(bar)[XB_TMO], 1u); break; } } } } while (0)
struct XcdBarrier { unsigned* bar; unsigned x; volatile LAS unsigned* st; };
DI XcdBarrier xcd_barrier_post(unsigned* bar, volatile LAS unsigned* st) {
  XcdBarrier b; b.bar = bar; b.x = xb_xcc_id(); b.st = st;
  if (threadIdx.x == 0) (void)xb_add(&bar[XB_XCNT(b.x)], 1u);
  return b;
}
DI void xcd_barrier_complete(unsigned* bar, unsigned x, unsigned& nloc, unsigned& nx) {
  const unsigned G = gridDim.x * gridDim.y * gridDim.z;
  unsigned sum, cnt, mine, sp = 0u;
  for (;;) {
    sum = 0u; cnt = 0u; mine = 0u;
#pragma unroll
    for (unsigned j = 0; j < 16; ++j) { const unsigned c = xb_ld(&bar[XB_XCNT(j)]); sum += c; cnt += (c > 0u) ? 1u : 0u; mine = (j == x) ? c : mine; }
    if (sum == G) break;
    __builtin_amdgcn_s_sleep(1);
    if ((++sp & 255u) == 0u) { if (xb_ld(&bar[XB_TMO])) break; if (sp > XB_SPIN_CAP) { atomicAdd(&bar[XB_TMO], 1u); break; } }
  }
  nloc = mine > 0u ? mine : 1u; nx = cnt > 0u ? cnt : 1u;
}
DI void xcd_barrier(const XcdBarrier& b) {
  asm volatile("s_waitcnt vmcnt(0)" ::: "memory");
  __syncthreads();
  if (threadIdx.x == 0) {
    unsigned* bar = b.bar;
    const unsigned bx = xb_xcc_id();
    __builtin_amdgcn_s_waitcnt(0);
    unsigned nloc = b.st[0], nx = b.st[1];
    if (nloc == 0u) { xcd_barrier_complete(bar, bx, nloc, nx); b.st[0] = nloc; b.st[1] = nx; }
    const unsigned old = xb_add(&bar[XB_XSUB(bx)], 1u);
    const unsigned gen = old / nloc;
    if (old + 1u == (gen + 1u) * nloc) {
      __builtin_amdgcn_fence(__ATOMIC_RELEASE, "agent");
      asm volatile("s_waitcnt vmcnt(0)" ::: "memory");
      const unsigned og = xb_add(&bar[XB_TOP], 1u);
      const unsigned tg = og / nx;
      if (og + 1u == (tg + 1u) * nx) xb_add(&bar[XB_TOPGEN], 1u);
      else XB_SPIN(xb_ld(&bar[XB_TOPGEN]) == tg, bar);
      __builtin_amdgcn_fence(__ATOMIC_ACQUIRE, "agent");
      xb_add(&bar[XB_XGEN(bx)], 1u);
      asm volatile("s_waitcnt vmcnt(0)" ::: "memory");
    } else {
      XB_SPIN(xb_ld(&bar[XB_XGEN(bx)]) == gen, bar);
      __builtin_amdgcn_fence(__ATOMIC_ACQUIRE, "agent");
      asm volatile("s_waitcnt vmcnt(0)" ::: "memory");
    }
  }
  __syncthreads();
}

DI const float* res_in_row(const Params& p, int layer, int g) {
  const int b = g / NT, n = g - b * NT;
  if (layer == 0) return n < L ? p.ctx + ((size_t)b * L + n) * D : p.x + ((size_t)b * T + (n - L)) * D;
  return n < L ? (const float*)(p.ws + WS_CTXR) + ((size_t)b * L + n) * D : p.out + ((size_t)b * T + (n - L)) * D;
}
DI float* res_out_row(const Params& p, int g) {
  const int b = g / NT, n = g - b * NT;
  return n < L ? (float*)(p.ws + WS_CTXR) + ((size_t)b * L + n) * D : p.out + ((size_t)b * T + (n - L)) * D;
}
DI int mod_vec(int g) { const int b = g / NT, n = g - b * NT; return n < L ? 2 : b; }
DI const float* mod_ptr(const Params& p, int layer, int v, int chunk) { return (const float*)(p.ws + WS_MOD) + ((size_t)(layer * 3 + v) * 6 + chunk) * D; }

__device__ __forceinline__ void phase_p0(const Params& p, unsigned char* smem) {
  const int tid = launder_tid();
  float* sc = (float*)smem;
  float* red = sc + 3 * 1024;
  for (int i = tid; i < 3 * 1024; i += NTHREADS) {
    const int v = i >> 10, d = i & 1023;
    const float x = v == 0 ? p.c[d] : (v == 1 ? p.c[1024 + d] : p.c_ctx[d]);
    sc[i] = silu_f(x);
  }
  __syncthreads();
  for (int u = blockIdx.x; u < 2 * 96; u += gridDim.x) {
    const int layer = u / 96, j0 = (u % 96) * 64;
    const int col = tid & 63, ds = tid >> 6;
    const float* w = p.w_ada + ((size_t)layer * D + ds * 128) * 6144 + j0 + col;
    float a0 = 0.f, a1 = 0.f, a2 = 0.f;
#pragma unroll 32
    for (int d = 0; d < 128; ++d) {
      const float wv = __builtin_nontemporal_load(w + (size_t)d * 6144);
      a0 += sc[ds * 128 + d] * wv; a1 += sc[1024 + ds * 128 + d] * wv; a2 += sc[2048 + ds * 128 + d] * wv;
    }
    red[(ds * 64 + col) * 3 + 0] = a0; red[(ds * 64 + col) * 3 + 1] = a1; red[(ds * 64 + col) * 3 + 2] = a2;
    __syncthreads();
    if (tid < 192) {
      const int v = tid / 64, cc = tid & 63;
      float s = p.b_ada[layer * 6144 + j0 + cc];
      for (int k = 0; k < 8; ++k) s += red[(k * 64 + cc) * 3 + v];
      ((float*)(p.ws + WS_MOD))[(size_t)(layer * 3 + v) * 6144 + j0 + cc] = s;
    }
    __syncthreads();
  }
  const int gt = blockIdx.x * NTHREADS + tid, nth = gridDim.x * NTHREADS;
  float* rope = (float*)(p.ws + WS_ROPE);
  for (int i = gt; i < 128 * 16; i += nth) {
    const int pos = i >> 4, k = i & 15;
    const float inv = powf(10000.0f, -(float)k / 16.0f);
    float sn, cs; sincosf((float)pos * inv, &sn, &cs);
    rope[i] = cs; rope[2048 + i] = sn;
  }
  float* lb = (float*)(p.ws + WS_LB);
  for (int i = gt; i < 2 * 2 * 512; i += nth) {
    const int layer = i >> 10, dir = (i >> 9) & 1, ch = i & 511;
    const float h0 = p.hg_lower[(dir * 2 + 0) * 512 + ch], h1 = p.hg_lower[(dir * 2 + 1) * 512 + ch];
    lb[i] = layer == 0 ? 0.f : 1.f / (1.f + expf(h0 - h1));
  }
}

__device__ __forceinline__ void phase_a0(const Params& p, int layer) {
  const int tid_ = launder_tid(), lane = tid_ & 63, wave = tid_ >> 6;
  const float* nw = p.norm1 + layer * D;
  bf16_t* H = (bf16_t*)(p.ws + WS_H);
  const bf16_t* YS = (const bf16_t*)(p.ws + WS_YS);
  for (int g = blockIdx.x * 8 + wave; g < NTOK; g += gridDim.x * 8) {
    const float* src = res_in_row(p, layer, g);
    const int v = mod_vec(g);
    f32x4 x[4];
#pragma unroll
    for (int i = 0; i < 4; ++i) x[i] = *(const f32x4*)(src + (i * 64 + lane) * 4);
    if (layer > 0) {
      const float* g5 = mod_ptr(p, layer - 1, v, 5);
      float* dst = res_out_row(p, g);
#pragma unroll
      for (int i = 0; i < 4; ++i) {
        const int col = (i * 64 + lane) * 4;
        const u32x2 y0 = *(const u32x2*)(YS + (size_t)(2 * g) * D + col), y1 = *(const u32x2*)(YS + (size_t)(2 * g + 1) * D + col);
        const f32x4 gg = *(const f32x4*)(g5 + col);
        x[i][0] += gg[0] * (bf_lo(y0[0]) + bf_lo(y1[0])); x[i][1] += gg[1] * (bf_hi(y0[0]) + bf_hi(y1[0]));
        x[i][2] += gg[2] * (bf_lo(y0[1]) + bf_lo(y1[1])); x[i][3] += gg[3] * (bf_hi(y0[1]) + bf_hi(y1[1]));
        *(f32x4*)(dst + col) = x[i];
      }
    }
    float ss = 0.f;
#pragma unroll
    for (int i = 0; i < 4; ++i) ss += x[i][0] * x[i][0] + x[i][1] * x[i][1] + x[i][2] * x[i][2] + x[i][3] * x[i][3];
    ss = wave_sum(ss);
    const float r = rsqrtf(ss * (1.f / D) + RMS_EPS);
    const float* sh = mod_ptr(p, layer, v, 0);
    const float* scl = mod_ptr(p, layer, v, 1);
#pragma unroll
    for (int i = 0; i < 4; ++i) {
      const int col = (i * 64 + lane) * 4;
      const f32x4 w4 = *(const f32x4*)(nw + col), s4 = *(const f32x4*)(sh + col), c4 = *(const f32x4*)(scl + col);
      float y[4];
#pragma unroll
      for (int k = 0; k < 4; ++k) y[k] = x[i][k] * r * w4[k] * (1.f + c4[k]) + s4[k];
      u32x2 o; o[0] = pk2(y[0], y[1]); o[1] = pk2(y[2], y[3]);
      *(u32x2*)(H + (size_t)g * D + col) = o;
    }
  }
}


struct AttnSt { f32x16 o0, o1; float m, l; };
DI void attn_init(AttnSt& st) { st.o0 = zero16(); st.o1 = zero16(); st.m = -1e30f; st.l = 0.f; }
DI void load_q(bf16x8 (&qf)[4], const bf16_t* qp) {
#pragma unroll
  for (int ks = 0; ks < 4; ++ks) qf[ks] = *(const bf16x8*)(qp + ks * 512);
}
DI void load_kv(bf16x8 (&kf)[4], u32x4 (&vf)[2][2], const bf16_t* kp  , const bf16_t* vp  ) {
#pragma unroll
  for (int ks = 0; ks < 4; ++ks) kf[ks] = *(const bf16x8*)(kp + ks * 512);
#pragma unroll
  for (int ks = 0; ks < 2; ++ks)
#pragma unroll
    for (int dt = 0; dt < 2; ++dt) {
      vf[ks][dt] = *(const u32x4*)(vp + dt * 1024 + ks * 16);
    }
}
DI f32x16 qk_tile(const bf16x8 (&kf)[4], const bf16x8 (&qf)[4]) {
  f32x16 s = zero16();
#pragma unroll
  for (int ks = 0; ks < 4; ++ks) s = MFMA32(kf[ks], qf[ks], s);
  return s;
}
DI void softmax_pv(AttnSt& st, const f32x16& s, const u32x4 (&vf)[2][2]) {
  float tm = s[0];
#pragma unroll
  for (int r = 1; r < 16; ++r) tm = fmaxf(tm, s[r]);
  tm = fmaxf(tm, __shfl_xor(tm, 32));
  const float mn = fmaxf(st.m, tm);
  const float alpha = __builtin_amdgcn_exp2f(st.m - mn);
  float pv[16]; float rs = 0.f;
#pragma unroll
  for (int r = 0; r < 16; ++r) { pv[r] = __builtin_amdgcn_exp2f(s[r] - mn); rs += pv[r]; }
  rs += __shfl_xor(rs, 32);
  st.l = st.l * alpha + rs; st.m = mn;
#pragma unroll
  for (int r = 0; r < 16; ++r) { st.o0[r] *= alpha; st.o1[r] *= alpha; }
#pragma unroll
  for (int ks = 0; ks < 2; ++ks) {
    u32x4 pp; pp[0] = pk2(pv[8 * ks], pv[8 * ks + 1]); pp[1] = pk2(pv[8 * ks + 2], pv[8 * ks + 3]); pp[2] = pk2(pv[8 * ks + 4], pv[8 * ks + 5]); pp[3] = pk2(pv[8 * ks + 6], pv[8 * ks + 7]);
    const bf16x8 pf = __builtin_bit_cast(bf16x8, pp);
    st.o0 = MFMA32(__builtin_bit_cast(bf16x8, vf[ks][0]), pf, st.o0);
    st.o1 = MFMA32(__builtin_bit_cast(bf16x8, vf[ks][1]), pf, st.o1);
  }
}
DI void attn_store(const AttnSt& st, bf16_t* dst, int h) {
  const float inv = 1.f / st.l;
#pragma unroll
  for (int q = 0; q < 4; ++q) {
    u32x2 o; o[0] = pk2(st.o0[4 * q] * inv, st.o0[4 * q + 1] * inv); o[1] = pk2(st.o0[4 * q + 2] * inv, st.o0[4 * q + 3] * inv);
    *(u32x2*)(dst + 8 * q + 4 * h) = o;
    u32x2 o2; o2[0] = pk2(st.o1[4 * q] * inv, st.o1[4 * q + 1] * inv); o2[1] = pk2(st.o1[4 * q + 2] * inv, st.o1[4 * q + 3] * inv);
    *(u32x2*)(dst + 32 + 8 * q + 4 * h) = o2;
  }
}
DI void attn_sink(AttnSt& st, float sk) {
  const float mf = fmaxf(st.m, sk), a = __builtin_amdgcn_exp2f(st.m - mf);
  st.l = st.l * a + __builtin_amdgcn_exp2f(sk - mf); st.m = mf;
#pragma unroll
  for (int rg = 0; rg < 16; ++rg) { st.o0[rg] *= a; st.o1[rg] *= a; }
}
DI void scale_plain(f32x16& s) {
#pragma unroll
  for (int r = 0; r < 16; ++r) s[r] *= 0.125f * LOG2E;
}
DI void attn_ctx_tiles2(AttnSt& sa, AttnSt& sb, const bf16x8 (&qa)[4], const bf16x8 (&qb)[4], const bf16_t* kbase, int kstride, const bf16_t* vbase, int lane, int rot) {
  const int h = lane >> 5, ql = lane & 31;
#pragma unroll 1
  for (int i_ = 0; i_ < 8; ++i_) {
    const int i = (i_ + rot) & 7;
    bf16x8 kf[4]; u32x4 vf[2][2];
    load_kv(kf, vf, kbase + (size_t)i * 2048 + ql * 16 + 8 * h, vbase + (size_t)i * 2048 + ql * 32 + 8 * h);
    f32x16 s0 = qk_tile(kf, qa), s1 = qk_tile(kf, qb);
    scale_plain(s0); scale_plain(s1);
    softmax_pv(sa, s0, vf); softmax_pv(sb, s1, vf);
  }
}

__device__ __forceinline__ void phase_attn(const Params& p, int layer, unsigned char* smem) {
  const int tid_ = launder_tid(), lane = tid_ & 63, wave = tid_ >> 6, h = lane >> 5, ql = lane & 31;
  const bf16_t* QA = (const bf16_t*)(p.ws + WS_QA); const bf16_t* KA = (const bf16_t*)(p.ws + WS_KA); const bf16_t* VAT = (const bf16_t*)(p.ws + WS_VAT);
  const bf16_t* QW = (const bf16_t*)(p.ws + WS_QW); const bf16_t* KW = (const bf16_t*)(p.ws + WS_KW); const bf16_t* VWT = (const bf16_t*)(p.ws + WS_VWT);
  bf16_t* YA = (bf16_t*)(p.ws + WS_Y); bf16_t* YC = YA + (size_t)2 * NTOK * 512;
  const float NEG_INF = -__builtin_inff();
  constexpr int NU_NA = NB * 8 * 128, NU_WA = NB * 2 * (T / 32) * 2, NU_C = NB * 8 * 4;
  const int nunits = NU_NA + NU_WA + (layer == 0 ? 2 * NU_C : 0);
#pragma unroll 1
  for (int u = (int)(gridDim.x - 1 - blockIdx.x) * 8 + wave; u < nunits; u += gridDim.x * 8) {
    AttnSt sa, sb; attn_init(sa); attn_init(sb);
    bf16x8 qa[4], qb[4];
    if (u < NU_NA) {
      const int r = u & 127, head = (u >> 7) & 7, b = u >> 10;
      const int gq = b * NT + L + r * 64 + ql;
      { const bf16_t* qt_ = QA + (size_t)(b * 8 + head) * 64 * NT + (size_t)((L + r * 64) >> 5) * 2048 + ql * 16 + 8 * h; load_q(qa, qt_); load_q(qb, qt_ + 2048); }
      const bf16_t* kb = KA + (size_t)(b * 8 + head) * 64 * NT;
      const bf16_t* vb = VAT + (size_t)(b * 8 + head) * 64 * NT;
      const int rs = min(max(r - 4, 0), 120);
      const int cqa = ql, cqb = 32 + ql;
      const int loa = min(max(cqa - 8, 0), 48), lob = min(max(cqb - 8, 0), 48);
      float* rpb = (float*)(smem + wave * 2048);
      { const float* rg_ = p.na_rpb + (size_t)(layer * 8 + head) * 15 * 31;
#pragma unroll
        for (int i_ = 0; i_ < 8; ++i_) { const int j_ = lane + 64 * i_; if (j_ < 465) rpb[j_] = rg_[j_]; } }
#pragma unroll 1
      for (int t = 0; t < 16; ++t) {
        const int kr = rs + (t >> 1), half = t & 1;
        const int n0 = L + kr * 64 + half * 32;
        bf16x8 kf[4]; u32x4 vf[2][2];
        load_kv(kf, vf, kb + (size_t)(n0 >> 5) * 2048 + ql * 16 + 8 * h, vb + (size_t)(n0 >> 5) * 2048 + ql * 32 + 8 * h);
        const float* brow = rpb + (kr - r + 7) * 31;
        f32x16 s0 = qk_tile(kf, qa), s1 = qk_tile(kf, qb);
#pragma unroll
        for (int rg = 0; rg < 16; ++rg) {
          const int kc = half * 32 + crow(rg, h);
          const bool oka = kc >= loa && kc < loa + 16, okb = kc >= lob && kc < lob + 16;
          const float ba = brow[min(max(kc - cqa + 15, 0), 30)], bb = brow[min(max(kc - cqb + 15, 0), 30)];
          s0[rg] = oka ? (s0[rg] * 0.125f + ba) * LOG2E : NEG_INF;
          s1[rg] = okb ? (s1[rg] * 0.125f + bb) * LOG2E : NEG_INF;
        }
        softmax_pv(sa, s0, vf); softmax_pv(sb, s1, vf);
      }
      attn_ctx_tiles2(sa, sb, qa, qb, kb, 512, vb, lane, wave);
      attn_store(sa, YA + (size_t)gq * 512 + head * 64, h);
      attn_store(sb, YA + (size_t)(gq + 32) * 512 + head * 64, h);
    } else if (u < NU_NA + NU_WA) {
      const int uu = u - NU_NA;
      const int qt = uu & 255, hp = (uu >> 8) & 1, kv = (uu >> 9) & 1, b = uu >> 10;
      const int ha = kv * 4 + hp * 2, hb = ha + 1;
      const int q0 = qt * 32, gq = b * NT + L + q0 + ql;
      { const size_t to_ = (size_t)((L + q0) >> 5) * 2048 + ql * 16 + 8 * h; load_q(qa, QW + (size_t)(b * 8 + ha) * 64 * NT + to_); load_q(qb, QW + (size_t)(b * 8 + hb) * 64 * NT + to_); }
      const bf16_t* kb = KW + (size_t)(b * 2 + kv) * 64 * NT;
      const bf16_t* vb = VWT + (size_t)(b * 2 + kv) * 64 * NT;
#pragma unroll 1
      for (int i = 0; i < 9; ++i) {
        const int k0 = q0 - 128 + 32 * i;
        if (k0 < 0 || k0 >= T) continue;
        bf16x8 kf[4]; u32x4 vf[2][2];
        load_kv(kf, vf, kb + (size_t)((L + k0) >> 5) * 2048 + ql * 16 + 8 * h, vb + (size_t)((L + k0) >> 5) * 2048 + ql * 32 + 8 * h);
        f32x16 s0 = qk_tile(kf, qa), s1 = qk_tile(kf, qb);
#pragma unroll
        for (int rg = 0; rg < 16; ++rg) {
          const int dlt = (k0 + crow(rg, h)) - (q0 + ql);
          const bool ok = dlt <= 128 && dlt >= -128;
          s0[rg] = ok ? s0[rg] * (0.125f * LOG2E) : NEG_INF;
          s1[rg] = ok ? s1[rg] * (0.125f * LOG2E) : NEG_INF;
        }
        softmax_pv(sa, s0, vf); softmax_pv(sb, s1, vf);
      }
      attn_ctx_tiles2(sa, sb, qa, qb, kb, 128, vb, lane, wave);
      attn_sink(sa, p.wa_sink[layer * 8 + ha] * LOG2E); attn_sink(sb, p.wa_sink[layer * 8 + hb] * LOG2E);
      attn_store(sa, YC + (size_t)gq * 512 + ha * 64, h);
      attn_store(sb, YC + (size_t)gq * 512 + hb * 64, h);
    } else if (u < NU_NA + NU_WA + NU_C) {
      const int uu = u - NU_NA - NU_WA;
      const int qp = uu & 3, head = (uu >> 2) & 7, b = uu >> 5;
      const int gq = b * NT + qp * 64 + ql;
      { const bf16_t* qt_ = QA + (size_t)(b * 8 + head) * 64 * NT + (size_t)(qp * 2) * 2048 + ql * 16 + 8 * h; load_q(qa, qt_); load_q(qb, qt_ + 2048); }
      attn_ctx_tiles2(sa, sb, qa, qb, KA + (size_t)(b * 8 + head) * 64 * NT, 512, VAT + (size_t)(b * 8 + head) * 64 * NT, lane, wave);
      attn_store(sa, YA + (size_t)gq * 512 + head * 64, h);
      attn_store(sb, YA + (size_t)(gq + 32) * 512 + head * 64, h);
    } else {
      const int uu = u - NU_NA - NU_WA - NU_C;
      const int qt = uu & 7, hp = (uu >> 3) & 1, kv = (uu >> 4) & 1, b = uu >> 5;
      const int ha = kv * 4 + hp * 2, hb = ha + 1;
      const int gq = b * NT + qt * 32 + ql;
      { const size_t to_ = (size_t)qt * 2048 + ql * 16 + 8 * h; load_q(qa, QW + (size_t)(b * 8 + ha) * 64 * NT + to_); load_q(qb, QW + (size_t)(b * 8 + hb) * 64 * NT + to_); }
      attn_ctx_tiles2(sa, sb, qa, qb, KW + (size_t)(b * 2 + kv) * 64 * NT, 128, VWT + (size_t)(b * 2 + kv) * 64 * NT, lane, wave);
      attn_sink(sa, p.wa_sink[layer * 8 + ha] * LOG2E); attn_sink(sb, p.wa_sink[layer * 8 + hb] * LOG2E);
      attn_store(sa, YC + (size_t)gq * 512 + ha * 64, h);
      attn_store(sb, YC + (size_t)gq * 512 + hb * 64, h);
    }
  }
}

DI int perm32(int rho) { return 8 * ((rho >> 2) & 3) + 4 * (rho >> 4) + (rho & 3); }
DI void conv_item(const float* W, int ldw, int k0, int c0, bf16_t* dst  , int Kd, float* scr, int lane, bool perm) {
  const float* wp = W + (size_t)(k0 + (lane >> 5)) * ldw + c0 + (lane & 31);
  float v[32];
#pragma unroll
  for (int i = 0; i < 32; ++i) v[i] = __builtin_nontemporal_load(wp + (size_t)(2 * i) * ldw);
#pragma unroll
  for (int i = 0; i < 32; ++i) scr[(2 * i + (lane >> 5)) * 33 + (lane & 31)] = v[i];
  asm volatile("s_waitcnt lgkmcnt(0)" ::: "memory");
  const int c = lane & 7;
#pragma unroll
  for (int j = 0; j < 4; ++j) {
    const int n = (lane >> 3) + 8 * j; const float* s = scr + (8 * c) * 33 + (perm ? perm32(n) : n);
    u32x4 o; o[0] = pk2(s[0 * 33], s[1 * 33]); o[1] = pk2(s[2 * 33], s[3 * 33]); o[2] = pk2(s[4 * 33], s[5 * 33]); o[3] = pk2(s[6 * 33], s[7 * 33]);
    *(u32x4*)(dst + (size_t)n * Kd + k0 + 8 * c) = o;
  }
  asm volatile("s_waitcnt lgkmcnt(0)" ::: "memory");
}
constexpr size_t WM_WIN = 0, WM_WG = WM_WIN + (size_t)PCOLS * D * 2, WM_WP = WM_WG + (size_t)3072 * D * 2, WM_WO = WM_WP + (size_t)3 * 1024 * 512 * 2, WM_END = WM_WO + (size_t)D * D * 2;
static_assert(WM_END <= WMIX_BYTES, "mixer weight buffer");
__device__ __forceinline__ void conv_mixer(const Params& p, int layer, unsigned char* smem) {
  const int tid = launder_tid(), lane = tid & 63, wave = tid >> 6;
  float* scr = (float*)smem + wave * (64 * 33);
  unsigned char* wm = p.ws + WS_WMIX;
  const float* Win = p.w_in + (size_t)layer * D * INC;
  constexpr int I_IN = 16 * (PCOLS / 32), I_G = 16 * (3072 / 32), I_P = 8 * 32, I_O = 16 * 32;
  for (int it = blockIdx.x * 8 + wave; it < I_IN + I_G + 3 * I_P + I_O; it += gridDim.x * 8) {
    int r = it;
    if (r < I_IN) {
      const int kb = r / (PCOLS / 32), rb = r % (PCOLS / 32), rho0 = rb * 32;
      const int tile = rho0 >> 8, bj = (rho0 >> 7) & 1, wc = (rho0 >> 5) & 3;
      conv_item(Win, INC, kb * 64, tile * 256 + 64 * wc + 32 * bj, (bf16_t*)(wm + WM_WIN) + (size_t)rho0 * D, D, scr, lane, tile >= 6 && tile < 16); continue;
    }
    r -= I_IN;
    if (r < I_G) { const int kb = r / 96, rb = r % 96; conv_item(Win, INC, kb * 64, PCOLS + rb * 32, (bf16_t*)(wm + WM_WG) + (size_t)rb * 32 * D, D, scr, lane, true); continue; }
    r -= I_G;
    if (r < 3 * I_P) {
      const int br = r / I_P, q = r % I_P, kb = q / 32, rb = q % 32;
      const float* Wp = (br == 0 ? p.w_pa : (br == 1 ? p.w_pb : p.w_pc)) + (size_t)layer * 512 * D;
      conv_item(Wp, D, kb * 64, rb * 32, (bf16_t*)(wm + WM_WP) + (size_t)br * 1024 * 512 + (size_t)rb * 32 * 512, 512, scr, lane, true); continue;
    }
    r -= 3 * I_P;
    { const int kb = r / 32, rb = r % 32; conv_item(p.w_out + (size_t)layer * D * D, D, kb * 64, rb * 32, (bf16_t*)(wm + WM_WO) + (size_t)rb * 32 * D, D, scr, lane, false); }
  }
}
constexpr size_t WE_PER = (size_t)1024 * 1024 * 2 + (size_t)1024 * 512 * 2;
static_assert(16 * WE_PER <= WEXP_BYTES, "expert weight buffer");
__device__ __forceinline__ void conv_experts(const Params& p, int layer, unsigned char* smem, int nwaves) {
  const int tid = launder_tid(), lane = tid & 63, wave = tid >> 6;
  float* scr = (float*)smem + wave * (64 * 33);
  constexpr int I_GU = 16 * 32, I_D = 8 * 32;
  for (int it = blockIdx.x * nwaves + wave; it < 16 * (I_GU + I_D); it += gridDim.x * nwaves) {
    const int e = it / (I_GU + I_D); int r = it % (I_GU + I_D);
    unsigned char* we = p.ws + WS_WEXP + (size_t)e * WE_PER;
    if (r < I_GU) {
      const int kb = r / 32, rb = r % 32, rho0 = rb * 32, t = rho0 >> 8, bj = (rho0 >> 7) & 1, wc = (rho0 >> 5) & 3;
      const float* W = (bj ? p.w_up : p.w_gate) + ((size_t)(layer * 16 + e) * D) * 512;
      conv_item(W, 512, kb * 64, 128 * t + 32 * wc, (bf16_t*)we + (size_t)rho0 * D, D, scr, lane, true);
    } else {
      r -= I_GU; const int kb = r / 32, rb = r % 32;
      conv_item(p.w_down + ((size_t)(layer * 16 + e) * 512) * D, D, kb * 64, rb * 32, (bf16_t*)(we + (size_t)1024 * 1024 * 2) + (size_t)rb * 32 * 512, 512, scr, lane, true);
    }
  }
}


DI int hg_tokblock(int dir, int c) { return dir == 0 ? c : (c < 4 ? 3 - c : 135 - c); }
DI int hg_chunk_of_block(int dir, int tb) { return dir == 0 ? tb : (tb < 4 ? 3 - tb : 135 - tb); }
constexpr int HP = 136;
constexpr int TP = 72;
constexpr int H_QE = 0, H_QR = H_QE + 64 * HP * 2, H_KR = H_QR + 64 * HP * 2, H_VT = H_KR + 4 * 64 * HP * 2, H_ATT = H_VT + 128 * TP * 2,
              H_SEG = H_ATT + 64 * TP * 2, H_RED = H_SEG + 4 * 128 * 4, H_END = H_RED + 2 * 4 * 32 * 4;
static_assert(H_END <= LDS_BYTES, "LDS");
constexpr int H1_KET = 0, H1_VT = H1_KET + 128 * TP * 2, H1_SEG = H1_VT + 128 * TP * 2;

DI float hg_gates(const bf16_t* fp  , float lbv, int dir, float (&kk)[16], float (&bl)[16]) {
  float lf[16];
#pragma unroll
  for (int i = 0; i < 16; ++i) {
    const float x = bf2f(fp[(size_t)i * 2560]);
    const float f = lbv + (1.f - lbv) * sigmoid_f(x);
    lf[i] = __logf(fmaxf(f, 1e-30f)); kk[i] = 1.f - f;
  }
  float run = 0.f;
  if (dir == 0) {
#pragma unroll
    for (int i = 0; i < 16; ++i) { run += lf[i]; bl[i] = run; }
  } else {
#pragma unroll
    for (int i = 15; i >= 0; --i) { run += lf[i]; bl[i] = run; }
  }
  return run;
}
DI float hg_gates_raw(const unsigned short (&raw)[16], float lbv, int dir, float (&kk)[16], float (&bl)[16]) {
  float lf[16];
#pragma unroll
  for (int i = 0; i < 16; ++i) {
    const float f = lbv + (1.f - lbv) * sigmoid_f(bf2f(raw[i]));
    lf[i] = __logf(fmaxf(f, 1e-30f)); kk[i] = 1.f - f;
  }
  float run = 0.f;
  if (dir == 0) {
#pragma unroll
    for (int i = 0; i < 16; ++i) { run += lf[i]; bl[i] = run; }
  } else {
#pragma unroll
    for (int i = 15; i >= 0; --i) { run += lf[i]; bl[i] = run; }
  }
  return run;
}
DI void pack16_store(bf16_t* dst, const float (&v)[16]) {
  u32x4 a, b;
#pragma unroll
  for (int i = 0; i < 4; ++i) { a[i] = pk2(v[2 * i], v[2 * i + 1]); b[i] = pk2(v[8 + 2 * i], v[8 + 2 * i + 1]); }
  *(u32x4*)dst = a; *(u32x4*)(dst + 8) = b;
}
DI void hg_load_vt(bf16_t* Vt, const bf16_t* HG, int g0, int head, int tid) {
  const int dv = tid & 127, seg = tid >> 7;
  const bf16_t* vp = HG + (size_t)(g0 + 16 * seg) * 2560 + 1536 + head * 128 + dv;
  unsigned short raw[16];
#pragma unroll
  for (int i = 0; i < 16; ++i) raw[i] = vp[(size_t)i * 2560];
  u32x4 a, b;
#pragma unroll
  for (int i = 0; i < 4; ++i) { a[i] = (unsigned)raw[2 * i] | ((unsigned)raw[2 * i + 1] << 16); b[i] = (unsigned)raw[8 + 2 * i] | ((unsigned)raw[8 + 2 * i + 1] << 16); }
  *(u32x4*)(Vt + dv * TP + 16 * seg) = a; *(u32x4*)(Vt + dv * TP + 16 * seg + 8) = b;
}

__device__ __forceinline__ void phase_hg_b1(const Params& p, int layer, unsigned char* smem) {
  const int tid = launder_tid(), lane = tid & 63, wave = tid >> 6, h = lane >> 5;
  const bf16_t* HG = (const bf16_t*)(p.ws + WS_HG);
  bf16_t* U = (bf16_t*)(p.ws + WS_U);
  float* DEC = (float*)(p.ws + WS_DEC);
  const float* LB = (const float*)(p.ws + WS_LB);
  bf16_t* KeT = (bf16_t*)(smem + H1_KET); bf16_t* Vt = (bf16_t*)(smem + H1_VT); float* segt = (float*)(smem + H1_SEG);
  const int cch = tid & 127, seg = tid >> 7;
  unsigned short rf_[16], rv_[16];
#define B1_ISSUE(u_) { const int chain_ = (u_) / NCHUNK, c_ = (u_) - chain_ * NCHUNK, head_ = chain_ & 3, dir_ = (chain_ >> 2) & 1, b_ = chain_ >> 3; \
    const bf16_t* bp_ = HG + (size_t)(b_ * NT + 64 * hg_tokblock(dir_, c_) + 16 * seg) * 2560 + head_ * 128 + cch; \
    _Pragma("unroll") for (int i_ = 0; i_ < 16; ++i_) { rf_[i_] = bp_[(size_t)i_ * 2560 + 512 * (1 + dir_)]; rv_[i_] = bp_[(size_t)i_ * 2560 + 1536]; } }
  int u0 = (int)blockIdx.x, us = (int)gridDim.x, ue = NCHAIN * NCHUNK;
  if (layer == 0 && gridDim.x == 256) {
    if (blockIdx.x >= 240) u0 = ue; else us = 240;
  }
  if (u0 < ue) B1_ISSUE(u0);
#pragma unroll 1
  for (int u = u0; u < ue; u += us) {
    const int chain = u / NCHUNK, c = u - chain * NCHUNK;
    const int head = chain & 3, dir = (chain >> 2) & 1;
    float kk[16], bl[16];
    const float lbv = LB[layer * 1024 + dir * 512 + head * 128 + cch];
    const float tot = hg_gates_raw(rf_, lbv, dir, kk, bl);
    segt[seg * 128 + cch] = tot;
    {
      u32x4 a, b2;
#pragma unroll
      for (int i = 0; i < 4; ++i) { a[i] = (unsigned)rv_[2 * i] | ((unsigned)rv_[2 * i + 1] << 16); b2[i] = (unsigned)rv_[8 + 2 * i] | ((unsigned)rv_[8 + 2 * i + 1] << 16); }
      *(u32x4*)(Vt + cch * TP + 16 * seg) = a; *(u32x4*)(Vt + cch * TP + 16 * seg + 8) = b2;
    }
    if (u + us < ue) B1_ISSUE(u + us);
    __syncthreads();
    const float t0 = segt[cch], t1 = segt[128 + cch], t2 = segt[256 + cch], t3 = segt[384 + cch];
    const float btot = (t0 + t1) + (t2 + t3);
    float pre;
    if (dir == 0) pre = seg == 0 ? 0.f : (seg == 1 ? t0 : (seg == 2 ? t0 + t1 : t0 + t1 + t2));
    else pre = seg == 3 ? 0.f : (seg == 2 ? t3 : (seg == 1 ? t3 + t2 : t3 + t2 + t1));
    float ke[16];
#pragma unroll
    for (int i = 0; i < 16; ++i) ke[i] = kk[i] * __expf(btot - (pre + bl[i]));
    pack16_store(KeT + cch * TP + 16 * seg, ke);
    if (seg == 0) DEC[(size_t)u * 128 + cch] = __expf(btot);
    __syncthreads();
    const int dkt = wave & 3;
#pragma unroll
    for (int k2 = 0; k2 < 2; ++k2) {
      const int dvt = 2 * (wave >> 2) + k2;
      f32x16 acc = zero16();
#pragma unroll
      for (int ks = 0; ks < 4; ++ks) {
        const bf16x8 af = *(const bf16x8*)(KeT + (dkt * 32 + (lane & 31)) * TP + ks * 16 + 8 * h);
        const bf16x8 bfr = *(const bf16x8*)(Vt + (dvt * 32 + (lane & 31)) * TP + ks * 16 + 8 * h);
        acc = MFMA32(af, bfr, acc);
      }
      bf16_t* dst = U + (size_t)u * 16384 + dvt * 4096 + (lane & 31) * 16 + dkt * 1024;
#pragma unroll
      for (int q = 0; q < 4; ++q) {
        u32x2 o; o[0] = pk2(acc[4 * q], acc[4 * q + 1]); o[1] = pk2(acc[4 * q + 2], acc[4 * q + 3]);
        *(u32x2*)(dst + (q >> 1) * 512 + 8 * (q & 1) + 4 * h) = o;
      }
    }
    __syncthreads();
  }
}

#undef B1_ISSUE
__device__ __forceinline__ void phase_hg_b2(const Params& p, int layer, unsigned char* smem) {
  const int tid = launder_tid(), wave = tid >> 6;
  if (wave < 4) { conv_experts(p, layer, smem, 4); return; }
  unsigned* U32 = (unsigned*)(p.ws + WS_U);
  const float* DEC = (const float*)(p.ws + WS_DEC);
  const int gt = blockIdx.x * 256 + (tid - 256), nth = gridDim.x * 256;
  for (int idx = gt; idx < NCHAIN * 8192; idx += nth) {
    const int chain = idx >> 13, e2 = idx & 8191, dk = (((2 * e2) >> 9) & 7) * 16 + ((2 * e2) & 15);
    unsigned* up = U32 + (size_t)chain * NCHUNK * 8192 + e2;
    const float* dp = DEC + (size_t)chain * NCHUNK * 128 + dk;
    float s0 = 0.f, s1 = 0.f;
    for (int c0 = 0; c0 < NCHUNK; c0 += 12) {
      unsigned uv[12]; f32x2 dv[12];
#pragma unroll
      for (int k = 0; k < 12; ++k) { uv[k] = up[(size_t)(c0 + k) * 8192]; dv[k] = *(const f32x2*)(dp + (c0 + k) * 128); }
#pragma unroll
      for (int k = 0; k < 12; ++k) {
        up[(size_t)(c0 + k) * 8192] = pk2(s0, s1);
        s0 = dv[k][0] * s0 + bf_lo(uv[k]); s1 = dv[k][1] * s1 + bf_hi(uv[k]);
      }
    }
  }
}

__device__ __forceinline__ void phase_hg_b3(const Params& p, int layer, unsigned char* smem, bool ctxpass) {
  const int tid = launder_tid(), lane = tid & 63, wave = tid >> 6, h = lane >> 5;
  const bf16_t* HG = (const bf16_t*)(p.ws + WS_HG);
  const bf16_t* U = (const bf16_t*)(p.ws + WS_U);
  const float* LB = (const float*)(p.ws + WS_LB);
  bf16_t* YB = (bf16_t*)(p.ws + WS_Y) + (size_t)NTOK * 512;
  bf16_t* Qe = (bf16_t*)(smem + H_QE); bf16_t* Qr = (bf16_t*)(smem + H_QR); bf16_t* Kr = (bf16_t*)(smem + H_KR);
  bf16_t* Vt = (bf16_t*)(smem + H_VT); bf16_t* Att = (bf16_t*)(smem + H_ATT); float* segt = (float*)(smem + H_SEG); float* red = (float*)(smem + H_RED);
  const int cch = tid & 127, seg = tid >> 7;
  if (!ctxpass && layer == 0) {
    const u32x4* s0 = (const u32x4*)HG; u32x4* d0 = (u32x4*)(p.ws + WS_HGX);
    for (int i = blockIdx.x * NTHREADS + tid; i < 512 * 320; i += gridDim.x * NTHREADS) {
      const int row = i / 320, c16 = i - row * 320, srow = row < 256 ? row : NT + row - 256;
      d0[i] = s0[(size_t)srow * 320 + c16];
    }
  }
  const int ntb = ctxpass ? 4 : NCHUNK - 4, tboff = ctxpass ? 0 : 4;
  for (int u = ctxpass ? (int)(gridDim.x - 1 - blockIdx.x) : (int)blockIdx.x; u < NB * 4 * ntb; u += gridDim.x) {
    const int tb = u % ntb + tboff, head = (u / ntb) & 3, b = u / (4 * ntb);
    const int g0 = b * NT + 64 * tb;
    const bf16_t* HGu = ctxpass ? (const bf16_t*)(p.ws + WS_HGX) - (size_t)b * (NT - 256) * 2560 : HG;
    const int dvt = wave & 3, it = wave >> 2;
    unsigned short rv_[16], rq_[16], rf0_[16], rf1_[16];
    {
      const bf16_t* bp = HGu + (size_t)(g0 + 16 * seg) * 2560 + head * 128 + cch;
#pragma unroll
      for (int i = 0; i < 16; ++i) { rv_[i] = bp[(size_t)i * 2560 + 1536]; rq_[i] = bp[(size_t)i * 2560]; rf0_[i] = bp[(size_t)i * 2560 + 512]; rf1_[i] = bp[(size_t)i * 2560 + 1024]; }
    }
    {
      u32x4 a, b2;
#pragma unroll
      for (int i = 0; i < 4; ++i) { a[i] = (unsigned)rv_[2 * i] | ((unsigned)rv_[2 * i + 1] << 16); b2[i] = (unsigned)rv_[8 + 2 * i] | ((unsigned)rv_[8 + 2 * i + 1] << 16); }
      *(u32x4*)(Vt + cch * TP + 16 * seg) = a; *(u32x4*)(Vt + cch * TP + 16 * seg + 8) = b2;
    }
    f32x16 oacc = zero16();
    float qs[16];
#pragma unroll
    for (int i = 0; i < 16; ++i) qs[i] = silu_f(bf2f(rq_[i]));
#pragma unroll
    for (int dir = 0; dir < 2; ++dir) {
      const int c = hg_chunk_of_block(dir, tb);
      const int chain = (b * 2 + dir) * 4 + head;
      const bf16_t* Sc = U + ((size_t)chain * NCHUNK + c) * 16384 + dvt * 4096 + (lane & 31) * 16 + 8 * h;
      bf16x8 sf[8];
#pragma unroll
      for (int ks = 0; ks < 8; ++ks) sf[ks] = *(const bf16x8*)(Sc + ks * 512);
      float kk[16], bl[16];
      const float lbv = LB[layer * 1024 + dir * 512 + head * 128 + cch];
      const float tot = dir == 0 ? hg_gates_raw(rf0_, lbv, 0, kk, bl) : hg_gates_raw(rf1_, lbv, 1, kk, bl);
      segt[seg * 128 + cch] = tot;
      __syncthreads();
      const float t0 = segt[cch], t1 = segt[128 + cch], t2 = segt[256 + cch], t3 = segt[384 + cch];
      float ref[4];
      if (dir == 0) { ref[0] = 0.f; ref[1] = t0; ref[2] = t0 + t1; ref[3] = t0 + t1 + t2; }
      else { ref[3] = 0.f; ref[2] = t3; ref[1] = t3 + t2; ref[0] = t3 + t2 + t1; }
      float pre = seg == 0 ? ref[0] : (seg == 1 ? ref[1] : (seg == 2 ? ref[2] : ref[3]));
#pragma unroll
      for (int i = 0; i < 16; ++i) {
        const int t = 16 * seg + i;
        const float bt = pre + bl[i];
        Qe[t * HP + cch] = f2bf(qs[i] * __expf(bt));
        Qr[t * HP + cch] = f2bf(qs[i] * __expf(bl[i]));
#pragma unroll
        for (int I = 0; I < 4; ++I) {
          const bool need = dir == 0 ? (I >= seg) : (I <= seg);
          if (need) Kr[(I * 64 + t) * HP + cch] = f2bf(kk[i] * __expf(fminf(ref[I] - bt, 60.f)));
        }
      }
      __syncthreads();
#pragma unroll
      for (int k2 = 0; k2 < 2; ++k2) {
        const int blk = wave * 2 + k2, I = blk >> 2, J = blk & 3;
        const bool valid = dir == 0 ? (J <= I) : (J >= I);
        f32x4 a4 = {0.f, 0.f, 0.f, 0.f};
        if (valid) {
#pragma unroll
          for (int ks = 0; ks < 4; ++ks) {
            const bf16x8 af = *(const bf16x8*)(Kr + (I * 64 + J * 16 + (lane & 15)) * HP + ks * 32 + 8 * (lane >> 4));
            const bf16x8 bfr = *(const bf16x8*)(Qr + (I * 16 + (lane & 15)) * HP + ks * 32 + 8 * (lane >> 4));
            a4 = MFMA16(af, bfr, a4);
          }
          if (I == J) {
            const int il = lane & 15;
#pragma unroll
            for (int r = 0; r < 4; ++r) { const int jl = 4 * (lane >> 4) + r; const bool ok = dir == 0 ? (jl <= il) : (jl >= il); a4[r] = ok ? a4[r] : 0.f; }
          }
        }
        u32x2 o; o[0] = pk2(a4[0], a4[1]); o[1] = pk2(a4[2], a4[3]);
        *(u32x2*)(Att + (I * 16 + (lane & 15)) * TP + J * 16 + 4 * (lane >> 4)) = o;
      }
      __syncthreads();
#pragma unroll
      for (int ks = 0; ks < 4; ++ks) {
        const bf16x8 af = *(const bf16x8*)(Vt + (dvt * 32 + (lane & 31)) * TP + ks * 16 + 8 * h);
        const bf16x8 bfr = *(const bf16x8*)(Att + (it * 32 + (lane & 31)) * TP + ks * 16 + 8 * h);
        oacc = MFMA32(af, bfr, oacc);
      }
#pragma unroll
      for (int ks = 0; ks < 8; ++ks) {
        const bf16x8 bfr = *(const bf16x8*)(Qe + (it * 32 + (lane & 31)) * HP + ks * 16 + 8 * h);
        oacc = MFMA32(sf[ks], bfr, oacc);
      }
      __syncthreads();
    }
    float ss = 0.f;
#pragma unroll
    for (int r = 0; r < 16; ++r) ss += oacc[r] * oacc[r];
    ss += __shfl_xor(ss, 32);
    if (h == 0) red[(it * 4 + dvt) * 32 + (lane & 31)] = ss;
    __syncthreads();
    const float tot = red[(it * 4 + 0) * 32 + (lane & 31)] + red[(it * 4 + 1) * 32 + (lane & 31)] + red[(it * 4 + 2) * 32 + (lane & 31)] + red[(it * 4 + 3) * 32 + (lane & 31)];
    const float rs = rsqrtf(tot * (1.f / 128.f) + RMS_EPS);
    const int g = g0 + it * 32 + (lane & 31);
    const float* nw = p.hg_norm + layer * 128;
#pragma unroll
    for (int q = 0; q < 4; ++q) {
      const int dv = dvt * 32 + 8 * q + 4 * h;
      const u32x2 gr = *(const u32x2*)(HGu + (size_t)g * 2560 + 2048 + head * 128 + dv);
      const f32x4 w4 = *(const f32x4*)(nw + dv);
      const float y0 = oacc[4 * q] * rs * w4[0] * silu_f(bf_lo(gr[0])), y1 = oacc[4 * q + 1] * rs * w4[1] * silu_f(bf_hi(gr[0]));
      const float y2 = oacc[4 * q + 2] * rs * w4[2] * silu_f(bf_lo(gr[1])), y3 = oacc[4 * q + 3] * rs * w4[3] * silu_f(bf_hi(gr[1]));
      u32x2 o; o[0] = pk2(y0, y1); o[1] = pk2(y2, y3);
      *(u32x2*)(YB + (size_t)g * 512 + head * 128 + dv) = o;
    }
    __syncthreads();
  }
}


namespace pg8 {
constexpr int BM = 256, BK = 64, HALF = 128, HTB = HALF * BK * 2, STAGE_BYTES = 8 * HTB, NXCD = 8, WGM = 8;
DI int lds_byte(int r, int c) { const int st = (r >> 4) * 2 + (c >> 5), rr = r & 15, cc = c & 31, ob = rr * 64 + cc * 2; return st * 1024 + (ob ^ (((ob >> 9) & 1) << 5)); }
DI void stage_rc(int b, int& R, int& C) { const int st = b / 1024, sb = b % 1024, swz = sb ^ (((sb >> 9) & 1) << 5); R = (st >> 1) * 16 + swz / 64; C = (st & 1) * 32 + (swz % 64) / 2; }
struct Unit { int pm, pn; const char* A; const char* B; int e, rb, cnt, rowbase; };
typedef f32x4 Acc[2][2][4][2];

DI void static_tile(int L, int nM, int nN, int& pm, int& pn) {
  const int nwg = nM * nN;
  int wgid = L; { const int q = nwg / NXCD, r = nwg % NXCD, xcd = wgid % NXCD, off = wgid / NXCD; wgid = (xcd < r ? xcd * (q + 1) : r * (q + 1) + (xcd - r) * q) + off; }
  const int nig = WGM * nN, gid = wgid / nig, fm = gid * WGM, gsz = (nM - fm) < WGM ? (nM - fm) : WGM;
  pm = fm + ((wgid % nig) % gsz); pn = (wgid % nig) / gsz;
}

template <class Job, bool PROJ>
DI void gemm_phase(LAS unsigned char* lds, const Job& S) {
  const int K = S.K; const bool GATHER = S.gather_rows;
  const int tid = launder_tid(), wid = __builtin_amdgcn_readfirstlane(tid >> 6), lane = tid & 63, wr = wid >> 2, wc = wid & 3, fr = lane & 15, fq = lane >> 4;
  const int nt = K / BK;
  unsigned voffB[2], oA[2][2], o2[2][2];
#pragma unroll
  for (int i = 0; i < 2; ++i) { int R, C; stage_rc(tid * 16 + i * 8192, R, C); voffB[i] = (unsigned)(R * K + C) * 2u; }
  const size_t kstep = (size_t)(BK * 2);
  const size_t hstep = (size_t)HALF * K * 2;
  const unsigned ldsw = (unsigned)wid * 1024u;
  const int aoff = lds_byte(wr * 64 + fr, fq * 8), boff = lds_byte(wc * 32 + fr, fq * 8);
#define PG8_SA(b, h) (((b) * 2 + (h)) * HTB)
#define PG8_SB(b, h) ((4 + (b) * 2 + (h)) * HTB)
#define PG8_STAGE(bufoff, gbase, voff) do { _Pragma("unroll") for (int _i = 0; _i < 2; ++_i) \
    __builtin_amdgcn_global_load_lds((const unsigned*)((const char*)(gbase) + (voff)[_i]), (LAS unsigned*)(lds + (bufoff) + ldsw + _i * 8192), 16, 0, 0); } while (0)
#define PG8_LDA(dst, b, h) do { _Pragma("unroll") for (int m = 0; m < 4; ++m) _Pragma("unroll") for (int k = 0; k < 2; ++k) dst[m][k] = *(const LAS bf16x8*)(lds + PG8_SA(b, h) + aoff + m * 2048 + k * 1024); } while (0)
#define PG8_LDB(dst, b, h) do { _Pragma("unroll") for (int n = 0; n < 2; ++n) _Pragma("unroll") for (int k = 0; k < 2; ++k) dst[n][k] = *(const LAS bf16x8*)(lds + PG8_SB(b, h) + boff + n * 2048 + k * 1024); } while (0)
#define PG8_MMA(ai, bj, At, Bt) do { __builtin_amdgcn_s_setprio(1); _Pragma("unroll") for (int m = 0; m < 4; ++m) _Pragma("unroll") for (int n = 0; n < 2; ++n) _Pragma("unroll") for (int k = 0; k < 2; ++k) \
    acc[ai][bj][m][n] = __builtin_amdgcn_mfma_f32_16x16x32_bf16(Bt[n][k], At[m][k], acc[ai][bj][m][n], 0, 0, 0); __builtin_amdgcn_s_setprio(0); } while (0)
#define PG8_WAIT_V(n) asm volatile("s_waitcnt vmcnt(" #n ")" ::: "memory")
#define PG8_WAIT_L(n) asm volatile("s_waitcnt lgkmcnt(" #n ")" ::: "memory")
#define PG8_BAR __builtin_amdgcn_s_barrier()
#define PG8_SCHED __builtin_amdgcn_sched_barrier(0)
  Unit cur, nxt; int ui = 0;
  if (!S.next(0, cur)) return;
  if (GATHER) S.gather(cur, oA);
  else {
#pragma unroll
    for (int h = 0; h < 2; ++h)
#pragma unroll
      for (int i = 0; i < 2; ++i) oA[h][i] = voffB[i] + (unsigned)(h * HALF * K) * 2u;
  }
  Acc acc;
#pragma unroll
  for (int a = 0; a < 2; ++a)
#pragma unroll
    for (int b = 0; b < 2; ++b)
#pragma unroll
      for (int m = 0; m < 4; ++m)
#pragma unroll
        for (int n = 0; n < 2; ++n) acc[a][b][m][n] = (f32x4){0.f, 0.f, 0.f, 0.f};
  bf16x8 At[4][2], B0[2][2], B1[2][2];
  const char* cA = cur.A; const char* cB = cur.B;
  PG8_STAGE(PG8_SB(0, 0), cB, voffB); PG8_STAGE(PG8_SB(0, 1), cB + hstep, voffB); PG8_STAGE(PG8_SA(0, 0), cA, oA[0]); PG8_STAGE(PG8_SA(0, 1), cA, oA[1]);
  if (wr == 1) PG8_BAR;
  PG8_WAIT_V(2); PG8_BAR;
  PG8_STAGE(PG8_SB(1, 0), cB + kstep, voffB); PG8_STAGE(PG8_SA(1, 0), cA + kstep, oA[0]); PG8_STAGE(PG8_SB(1, 1), cB + hstep + kstep, voffB);
  PG8_WAIT_V(6); PG8_BAR;
  for (;;) {
    const bool has_next = S.next(ui + 1, nxt);
    const char* nA = has_next ? nxt.A : cA; const char* nB = has_next ? nxt.B : cB;
    for (int t = 0; t < nt; t += 2) {
      const bool last = (t == nt - 2);
      const char* a1 = cA + (size_t)(t + 1) * kstep;
      const char* a2 = last ? nA : cA + (size_t)(t + 2) * kstep; const char* b2 = last ? nB : cB + (size_t)(t + 2) * kstep;
      const char* a3 = a2 + kstep; const char* b3 = b2 + kstep;
      if (GATHER && last && has_next) S.gather(nxt, o2);
      else {
#pragma unroll
        for (int h = 0; h < 2; ++h)
#pragma unroll
          for (int i = 0; i < 2; ++i) o2[h][i] = oA[h][i];
      }
      PG8_LDB(B0, 0, 0); PG8_LDB(B1, 0, 1); PG8_SCHED; PG8_LDA(At, 0, 0); PG8_STAGE(PG8_SA(1, 1), a1, oA[1]);
      PG8_WAIT_V(8); PG8_WAIT_L(0); PG8_BAR; PG8_MMA(0, 0, At, B0); PG8_MMA(0, 1, At, B1); PG8_BAR; PG8_SCHED;
      PG8_LDA(At, 0, 1); PG8_STAGE(PG8_SB(0, 0), b2, voffB); PG8_STAGE(PG8_SB(0, 1), b2 + hstep, voffB); PG8_STAGE(PG8_SA(0, 0), a2, o2[0]);
      PG8_WAIT_V(8); PG8_WAIT_L(0); PG8_BAR; PG8_MMA(1, 0, At, B0); PG8_MMA(1, 1, At, B1); PG8_BAR; PG8_SCHED;
      PG8_LDB(B0, 1, 0); PG8_LDB(B1, 1, 1); PG8_SCHED; PG8_LDA(At, 1, 0); PG8_STAGE(PG8_SA(0, 1), a2, o2[1]);
      PG8_WAIT_V(8); PG8_WAIT_L(0); PG8_BAR; PG8_MMA(0, 0, At, B0); PG8_MMA(0, 1, At, B1); PG8_BAR; PG8_SCHED;
      PG8_LDA(At, 1, 1); PG8_STAGE(PG8_SB(1, 0), b3, voffB); PG8_STAGE(PG8_SB(1, 1), b3 + hstep, voffB); PG8_STAGE(PG8_SA(1, 0), a3, o2[0]);
      PG8_WAIT_V(8); PG8_WAIT_L(0); PG8_BAR; PG8_MMA(1, 0, At, B0); PG8_MMA(1, 1, At, B1); PG8_BAR; PG8_SCHED;
    }
    if (wr == 0) PG8_BAR;
    { int fr_ = fr, fq_ = fq; asm volatile("" : "+v"(fr_), "+v"(fq_));
      if (PROJ) S.epilogue_proj(acc, cur, wr, wc, fr_, fq_); else S.epilogue(acc, cur, wr, wc, fr_, fq_); }
    if (!has_next) break;
    if (!(PROJ && cur.e < 2)) {
#pragma unroll
      for (int a = 0; a < 2; ++a)
#pragma unroll
        for (int b = 0; b < 2; ++b)
#pragma unroll
          for (int m = 0; m < 4; ++m)
#pragma unroll
            for (int n = 0; n < 2; ++n) acc[a][b][m][n] = (f32x4){0.f, 0.f, 0.f, 0.f};
    }
    cur = nxt; cA = nA; cB = nB; ++ui;
    if (GATHER) {
#pragma unroll
      for (int h = 0; h < 2; ++h)
#pragma unroll
        for (int i = 0; i < 2; ++i) oA[h][i] = o2[h][i];
    }
    if (wr == 1) PG8_BAR;
  }
  PG8_WAIT_V(0);
  PG8_BAR;
#undef PG8_SA
#undef PG8_SB
#undef PG8_STAGE
#undef PG8_LDA
#undef PG8_LDB
#undef PG8_MMA
#undef PG8_WAIT_V
#undef PG8_WAIT_L
#undef PG8_BAR
#undef PG8_SCHED
}
}
constexpr int C3_MAXTOK = 272;
__device__ __forceinline__ void phase_c3(const Params& p, int layer, unsigned char* smem) {
  const int tid = launder_tid(), lane = tid & 63, wave = tid >> 6;
  float* wr = (float*)smem;
  int* lcount = (int*)(smem + 65536);
  int* lbase = lcount + 16;
  int* tok_e = lbase + 16;
  int* tok_pos = tok_e + 2 * C3_MAXTOK;
  for (int i = tid; i < 16 * 1024; i += NTHREADS) { const int col = i >> 4, e = i & 15; wr[e * 1024 + col] = p.w_router[i]; }
  if (tid < 16) lcount[tid] = 0;
  __syncthreads();
  const float* nw = p.norm2 + layer * D;
  bf16_t* HX = (bf16_t*)(p.ws + WS_HX);
  float* WTS = (float*)(p.ws + WS_WTS);
  int* LIST = (int*)(p.ws + WS_LIST);
  int* CNT = (int*)(p.ws + WS_CNT) + layer * 16;
  int li = wave;
  for (int g = blockIdx.x * 8 + wave; g < NTOK; g += gridDim.x * 8, li += 8) {
    if (layer == 1 && (g % NT) < L) continue;
    const float* src = res_in_row(p, 1, g);
    const int v = mod_vec(g);
    f32x4 x[4];
#pragma unroll
    for (int i = 0; i < 4; ++i) x[i] = *(const f32x4*)(src + (i * 64 + lane) * 4);
    float ss = 0.f;
#pragma unroll
    for (int i = 0; i < 4; ++i) ss += x[i][0] * x[i][0] + x[i][1] * x[i][1] + x[i][2] * x[i][2] + x[i][3] * x[i][3];
    ss = wave_sum(ss);
    const float r = rsqrtf(ss * (1.f / D) + RMS_EPS);
    const float* sh = mod_ptr(p, layer, v, 3);
    const float* scl = mod_ptr(p, layer, v, 4);
    float lg[16];
#pragma unroll
    for (int e = 0; e < 16; ++e) lg[e] = 0.f;
#pragma unroll
    for (int i = 0; i < 4; ++i) {
      const int col = (i * 64 + lane) * 4;
      const f32x4 w4 = *(const f32x4*)(nw + col), s4 = *(const f32x4*)(sh + col), c4 = *(const f32x4*)(scl + col);
      float y[4];
#pragma unroll
      for (int k = 0; k < 4; ++k) y[k] = x[i][k] * r * w4[k] * (1.f + c4[k]) + s4[k];
      u32x2 o; o[0] = pk2(y[0], y[1]); o[1] = pk2(y[2], y[3]);
      *(u32x2*)(HX + (size_t)g * D + col) = o;
#pragma unroll
      for (int e = 0; e < 16; ++e) {
        const f32x4 wv = *(const f32x4*)(wr + e * 1024 + col);
        lg[e] += y[0] * wv[0] + y[1] * wv[1] + y[2] * wv[2] + y[3] * wv[3];
      }
    }
#pragma unroll
    for (int e = 0; e < 16; ++e) lg[e] = wave_sum(lg[e]);
    float mx = lg[0];
#pragma unroll
    for (int e = 1; e < 16; ++e) mx = fmaxf(mx, lg[e]);
    float pr[16], den = 0.f;
#pragma unroll
    for (int e = 0; e < 16; ++e) { pr[e] = expf(lg[e] - mx); den += pr[e]; }
    const float inv = 1.f / den;
    float sel[16];
#pragma unroll
    for (int e = 0; e < 16; ++e) { pr[e] *= inv; sel[e] = pr[e] + p.b_router[e]; }
    int bg = 0; float bs = -__builtin_inff();
#pragma unroll
    for (int gi = 0; gi < 4; ++gi) {
      float a = -__builtin_inff(), b2 = -__builtin_inff();
#pragma unroll
      for (int k = 0; k < 4; ++k) { const float s = sel[gi * 4 + k]; if (s > a) { b2 = a; a = s; } else if (s > b2) b2 = s; }
      const float sc = a + b2;
      if (sc > bs) { bs = sc; bg = gi; }
    }
    float sg[4], pg[4];
#pragma unroll
    for (int k = 0; k < 4; ++k) { sg[k] = bg == 0 ? sel[k] : (bg == 1 ? sel[4 + k] : (bg == 2 ? sel[8 + k] : sel[12 + k])); pg[k] = bg == 0 ? pr[k] : (bg == 1 ? pr[4 + k] : (bg == 2 ? pr[8 + k] : pr[12 + k])); }
    int i0 = 0; float s0 = sg[0], p0 = pg[0];
#pragma unroll
    for (int k = 1; k < 4; ++k) if (sg[k] > s0) { s0 = sg[k]; p0 = pg[k]; i0 = k; }
    int i1 = 0; float s1 = -__builtin_inff(), p1 = 0.f;
#pragma unroll
    for (int k = 0; k < 4; ++k) if (k != i0 && sg[k] > s1) { s1 = sg[k]; p1 = pg[k]; i1 = k; }
    const int e0 = bg * 4 + i0, e1 = bg * 4 + i1;
    if (lane == 0) {
      const float wsum = p0 + p1;
      WTS[2 * g] = p0 / wsum; WTS[2 * g + 1] = p1 / wsum;
      tok_e[2 * li] = e0; tok_e[2 * li + 1] = e1;
      tok_pos[2 * li] = atomicAdd(&lcount[e0], 1); tok_pos[2 * li + 1] = atomicAdd(&lcount[e1], 1);
    }
  }
  __syncthreads();
  if (tid < 16) lbase[tid] = atomicAdd(&CNT[tid], lcount[tid]);
  __syncthreads();
  li = wave;
  for (int g = blockIdx.x * 8 + wave; g < NTOK; g += gridDim.x * 8, li += 8) {
    if (layer == 1 && (g % NT) < L) continue;
    if (lane < 2) { const int e = tok_e[2 * li + lane]; LIST[(size_t)e * NTOK + lbase[e] + tok_pos[2 * li + lane]] = 2 * g + lane; }
  }
}

struct MoeUnit { int e, rb, cnt, rowbase; };
DI bool moe_unit(const int* CNT, int rbg, MoeUnit& mu) {
  int acc = 0, rowbase = 0;
  mu.e = 0; mu.rb = 0; mu.cnt = 1; mu.rowbase = 0;
  for (int e = 0; e < 16; ++e) {
    const int c = CNT[e], nb = (c + 255) >> 8;
    if (rbg < acc + nb) { mu.e = e; mu.rb = rbg - acc; mu.cnt = c; mu.rowbase = rowbase; return true; }
    acc += nb; rowbase += nb * 256;
  }
  return false;
}
DI int moe_total_rb(const int* CNT) { int acc = 0; for (int e = 0; e < 16; ++e) acc += (CNT[e] + 255) >> 8; return acc; }


DI int row_tile_map(int pm, bool latent_only) { return latent_only ? (pm < 32 ? pm + 1 : pm + 2) : pm; }
struct DenseSched {
  const char* A; const char* B; int nM, nN, K, G, c; bool latent_only; bool rev_n;
  DI bool next(int i, pg8::Unit& u) const {
    const int Lx = i * G + c; if (Lx >= nM * nN) return false;
    int pm, pn; pg8::static_tile(Lx, nM, nN, pm, pn); pm = row_tile_map(pm, latent_only);
    if (rev_n) pn = nN - 1 - pn;
    u.pm = pm; u.pn = pn; u.A = A + (size_t)pm * 256 * K * 2; u.B = B + (size_t)pn * 256 * K * 2; u.e = 0; return true;
  }
};
struct ProjSched {
  const char* Y; const char* Wp; int nM, G, c; bool latent_only;
  DI bool next(int i, pg8::Unit& u) const {
    const int br = i % 3, Lx = (i / 3) * G + c; if (Lx >= nM * 4) return false;
    int pm, pn; pg8::static_tile(Lx, nM, 4, pm, pn); pm = row_tile_map(pm, latent_only);
    u.pm = pm; u.pn = pn; u.e = br;
    u.A = Y + ((size_t)br * NTOK + (size_t)pm * 256) * 512 * 2; u.B = Wp + ((size_t)br * 1024 + (size_t)pn * 256) * 512 * 2; return true;
  }
};
struct MoeSched {
  const int* desc; const int* LIST; const char* Abase; const char* Wexp; bool gate;
  DI bool next(int i, pg8::Unit& u) const {
    if (i >= 16) return false;
    const int e = __builtin_amdgcn_readfirstlane(desc[i * 8 + 0]); if (e < 0) return false;
    u.pm = i; u.e = e; u.rb = __builtin_amdgcn_readfirstlane(desc[i * 8 + 1]); u.cnt = __builtin_amdgcn_readfirstlane(desc[i * 8 + 2]);
    u.rowbase = __builtin_amdgcn_readfirstlane(desc[i * 8 + 3]); u.pn = __builtin_amdgcn_readfirstlane(desc[i * 8 + 4]);
    const char* we = Wexp + (size_t)e * WE_PER;
    if (gate) { u.A = Abase; u.B = we + (size_t)u.pn * 256 * D * 2; }
    else { u.A = Abase + (size_t)(u.rowbase + u.rb * 256) * 512 * 2; u.B = we + (size_t)1024 * 1024 * 2 + (size_t)u.pn * 256 * 512 * 2; }
    return true;
  }
  DI void gather(const pg8::Unit& u, unsigned (&o)[2][2]) const {
    const int tid = launder_tid(); int RA[2], CA[2];
#pragma unroll
    for (int i = 0; i < 2; ++i) pg8::stage_rc(tid * 16 + i * 8192, RA[i], CA[i]);
    const int* rows = desc + 16 * 8 + u.pm * 256;
#pragma unroll
    for (int h = 0; h < 2; ++h)
#pragma unroll
      for (int i = 0; i < 2; ++i) o[h][i] = (unsigned)(rows[h * 128 + RA[i]] * D + CA[i]) * 2u;
  }
};
DI int* moe_build_desc(const int* CNT, const int* LIST, bool rows_too, unsigned char* smem) {
  int* desc = (int*)(smem + 131072);
  const int tid = launder_tid();
  __syncthreads();
  if (tid < 16) {
    const int Lx = tid * (int)gridDim.x + (int)blockIdx.x;
    MoeUnit mu; const bool ok = moe_unit(CNT, Lx >> 2, mu);
    desc[tid * 8 + 0] = ok ? mu.e : -1; desc[tid * 8 + 1] = mu.rb; desc[tid * 8 + 2] = mu.cnt; desc[tid * 8 + 3] = mu.rowbase; desc[tid * 8 + 4] = Lx & 3;
  }
  __syncthreads();
  if (rows_too) {
    for (int s = 0; s < 3; ++s) {
      const int e = desc[s * 8 + 0];
      if (e >= 0 && tid < 256) {
        const int rb = desc[s * 8 + 1], cnt = desc[s * 8 + 2];
        const int ri = min(rb * 256 + tid, cnt - 1);
        desc[16 * 8 + s * 256 + tid] = LIST[(size_t)e * NTOK + ri] >> 1;
      }
    }
    if (tid == 0 && desc[3 * 8 + 0] >= 0) desc[3 * 8 + 0] = -1;
    __syncthreads();
  }
  return desc;
}

DI void st8bf(bf16_t* dst, const f32x4& a, const f32x4& b) { u32x4 o; o[0] = pk2(a[0], a[1]); o[1] = pk2(a[2], a[3]); o[2] = pk2(b[0], b[1]); o[3] = pk2(b[2], b[3]); *(u32x4*)dst = o; }
DI void st4bf(bf16_t* dst, float a, float b, float c, float d) { u32x2 o; o[0] = pk2(a, b); o[1] = pk2(c, d); *(u32x2*)dst = o; }
DI void quad_transpose(float (&a)[4], int q) {
  const bool o1 = (q & 1) != 0, o2 = (q & 2) != 0;
  const float r0 = shfl_x1(o1 ? a[0] : a[1]), r1 = shfl_x1(o1 ? a[2] : a[3]);
  const float p00 = o1 ? r0 : a[0], p01 = o1 ? a[1] : r0, p10 = o1 ? r1 : a[2], p11 = o1 ? a[3] : r1;
  const float u0 = shfl_x2(o2 ? p00 : p10), u1 = shfl_x2(o2 ? p01 : p11);
  a[0] = o2 ? u0 : p00; a[1] = o2 ? u1 : p01; a[2] = o2 ? p10 : u0; a[3] = o2 ? p11 : u1;
}
struct EpiA1 {
  const Params* pp; int layer;
  DI void operator()(const pg8::Acc& acc, const pg8::Unit& u, int wr, int wc, int fr, int fq) const {
    const Params& p = *pp; const int pn = u.pn;
    const float* rope = (const float*)(p.ws + WS_ROPE);
#pragma unroll
    for (int ai = 0; ai < 2; ++ai)
#pragma unroll
      for (int m = 0; m < 4; ++m) {
        const int g = u.pm * 256 + ai * 128 + wr * 64 + m * 16 + fr;
        const int b = g / NT, n = g - b * NT;
        float v[2][2][4];
#pragma unroll
        for (int bj = 0; bj < 2; ++bj)
#pragma unroll
          for (int n2 = 0; n2 < 2; ++n2)
#pragma unroll
            for (int i = 0; i < 4; ++i) v[bj][n2][i] = acc[ai][bj][m][n2][i];
        const bool is_v = (pn == 4 || pn == 5 || (pn == 18 && wc >= 2));
        const bool is_hg = (pn >= 6 && pn < 16);
        if (is_hg) {
          bf16_t* dst = (bf16_t*)(p.ws + WS_HG) + (size_t)g * 2560 + (pn * 256 - 1536) + 64 * wc + 8 * fq;
#pragma unroll
          for (int bj = 0; bj < 2; ++bj) st8bf(dst + 32 * bj, acc[ai][bj][m][0], acc[ai][bj][m][1]);
        } else if (is_v) {
          const int q = fr & 3;
          bf16_t* dst = (pn == 18 ? (bf16_t*)(p.ws + WS_VWT) + ((size_t)(b * 2 + (wc - 2)) * 64) * NT
                                  : (bf16_t*)(p.ws + WS_VAT) + ((size_t)(b * 8 + (pn - 4) * 4 + wc) * 64) * NT) + (size_t)((n - q) >> 5) * 2048 + (((n - q) & 0x13) | (((n - q) & 4) << 1) | (((n - q) & 8) >> 1));
#pragma unroll
          for (int bj = 0; bj < 2; ++bj)
#pragma unroll
            for (int n2 = 0; n2 < 2; ++n2) {
              quad_transpose(v[bj][n2], q);
              st4bf(dst + (32 * bj + 16 * n2 + 4 * fq + q) * 32, v[bj][n2][0], v[bj][n2][1], v[bj][n2][2], v[bj][n2][3]);
            }
        } else {
          const bool wa = pn >= 16;
          const bool isq = (pn < 2) || (pn == 16 || pn == 17);
          float ss = 0.f;
#pragma unroll
          for (int bj = 0; bj < 2; ++bj)
#pragma unroll
            for (int n2 = 0; n2 < 2; ++n2)
#pragma unroll
              for (int i = 0; i < 4; ++i) ss += v[bj][n2][i] * v[bj][n2][i];
          ss += __shfl_xor(ss, 16); ss += __shfl_xor(ss, 32);
          const float rs = rsqrtf(ss * (1.f / 64.f) + RMS_EPS);
          const float* nw = (wa ? (isq ? p.wa_qn : p.wa_kn) : (isq ? p.na_qn : p.na_kn)) + layer * 64;
#pragma unroll
          for (int bj = 0; bj < 2; ++bj)
#pragma unroll
            for (int n2 = 0; n2 < 2; ++n2) {
              const f32x4 w4 = *(const f32x4*)(nw + 32 * bj + 16 * n2 + 4 * fq);
#pragma unroll
              for (int i = 0; i < 4; ++i) v[bj][n2][i] *= rs * w4[i];
            }
          if (wa && n >= L) {
            const int t = n - L;
#pragma unroll
            for (int bj = 0; bj < 2; ++bj) {
              const int pos = bj == 0 ? (t >> 6) : (t & 63);
              const f32x4 cs = *(const f32x4*)(rope + pos * 16 + 4 * fq), sn = *(const f32x4*)(rope + 2048 + pos * 16 + 4 * fq);
#pragma unroll
              for (int i = 0; i < 4; ++i) { const float x1 = v[bj][0][i], x2 = v[bj][1][i]; v[bj][0][i] = x1 * cs[i] - x2 * sn[i]; v[bj][1][i] = x2 * cs[i] + x1 * sn[i]; }
            }
          }
          bf16_t* dst;
          if (pn < 2) dst = (bf16_t*)(p.ws + WS_QA) + (size_t)(b * 8 + pn * 4 + wc) * 64 * NT + (size_t)(n >> 5) * 2048 + (n & 31) * 16;
          else if (pn < 4) dst = (bf16_t*)(p.ws + WS_KA) + (size_t)(b * 8 + (pn - 2) * 4 + wc) * 64 * NT + (size_t)(n >> 5) * 2048 + (n & 31) * 16;
          else if (pn < 18) dst = (bf16_t*)(p.ws + WS_QW) + (size_t)(b * 8 + (pn - 16) * 4 + wc) * 64 * NT + (size_t)(n >> 5) * 2048 + (n & 31) * 16;
          else dst = (bf16_t*)(p.ws + WS_KW) + (size_t)(b * 2 + wc) * 64 * NT + (size_t)(n >> 5) * 2048 + (n & 31) * 16;
#pragma unroll
          for (int bj = 0; bj < 2; ++bj)
#pragma unroll
            for (int n2 = 0; n2 < 2; ++n2) {
              const bool isk = true;
              st4bf(dst + (isk ? (2 * bj + n2) * 512 + 4 * fq : 32 * bj + 16 * n2 + 4 * fq), v[bj][n2][0], v[bj][n2][1], v[bj][n2][2], v[bj][n2][3]);
            }
        }
      }
  }
};
struct EpiGate {
  bf16_t* G;
  DI void operator()(const pg8::Acc& acc, const pg8::Unit& u, int wr, int wc, int fr, int fq) const {
#pragma unroll
    for (int ai = 0; ai < 2; ++ai)
#pragma unroll
      for (int m = 0; m < 4; ++m) {
        bf16_t* rowp = G + (size_t)(u.pm * 12 + u.pn) * 65536 + ((((ai * 2 + wr) * 4 + m) * 8 + wc) * 512) + (fr * 4 + fq) * 8;
#pragma unroll
        for (int bj = 0; bj < 2; ++bj) {
          f32x4 a = acc[ai][bj][m][0], c = acc[ai][bj][m][1];
#pragma unroll
          for (int i = 0; i < 4; ++i) { a[i] = sigmoid_f(a[i]); c[i] = sigmoid_f(c[i]); }
          st8bf(rowp + 2048 * bj, a, c);
        }
      }
  }
};
struct EpiProj {
  const bf16_t* G; bf16_t* M;
  DI void operator()(pg8::Acc& acc, const pg8::Unit& u, int wr, int wc, int fr, int fq) const {
    const int br = u.e;
#pragma unroll
    for (int ai = 0; ai < 2; ++ai)
#pragma unroll
      for (int m = 0; m < 4; ++m) {
        const size_t g = (size_t)(u.pm * 256 + ai * 128 + wr * 64 + m * 16 + fr);
        const int col0 = u.pn * 256 + 32 * wc + 8 * fq;
        const bf16_t* gp = G + (size_t)(u.pm * 12 + br * 4 + u.pn) * 65536 + ((((ai * 2 + wr) * 4 + m) * 8 + wc) * 512) + (fr * 4 + fq) * 8;
        asm volatile("" : "+v"(gp) :: "memory");
#pragma unroll
        for (int bj = 0; bj < 2; ++bj) {
          const u32x4 gg = *(const u32x4*)(gp + 2048 * bj);
          u32x4 gn = gg;
          if (br < 2) gn = *(const u32x4*)(gp + 4 * 65536 + 2048 * bj);
#pragma unroll
          for (int hq = 0; hq < 2; ++hq) {
            f32x4 a = acc[ai][bj][m][hq];
#pragma unroll
            for (int e = 0; e < 4; ++e) {
              const unsigned gw = gg[2 * hq + (e >> 1)], nw = gn[2 * hq + (e >> 1)];
              float s = (e & 1) ? bf_hi(gw) : bf_lo(gw);
              if (br > 0) s = fmaxf(s, 1e-6f);
              if (br < 2) s *= __builtin_amdgcn_rcpf(fmaxf((e & 1) ? bf_hi(nw) : bf_lo(nw), 1e-6f));
              a[e] *= s;
            }
            acc[ai][bj][m][hq] = a;
          }
          if (br == 2) st8bf(M + g * D + col0 + 128 * bj, acc[ai][bj][m][0], acc[ai][bj][m][1]);
        }
      }
  }
};
struct EpiOut {
  const Params* pp; int layer;
  DI void operator()(const pg8::Acc& acc, const pg8::Unit& u, int wr, int wc, int fr, int fq) const {
    const Params& p = *pp;
#pragma unroll
    for (int ai = 0; ai < 2; ++ai)
#pragma unroll
      for (int m = 0; m < 4; ++m) {
        const int g = u.pm * 256 + ai * 128 + wr * 64 + m * 16 + fr;
        const float* src = res_in_row(p, layer, g); float* dst = res_out_row(p, g);
        const float* g2 = mod_ptr(p, layer, mod_vec(g), 2);
#pragma unroll
        for (int bj = 0; bj < 2; ++bj)
#pragma unroll
          for (int n = 0; n < 2; ++n) {
            const int col = u.pn * 256 + 128 * bj + 32 * wc + 16 * n + 4 * fq;
            const f32x4 xr = *(const f32x4*)(src + col), gg = *(const f32x4*)(g2 + col), a = acc[ai][bj][m][n];
            f32x4 o; o[0] = xr[0] + gg[0] * a[0]; o[1] = xr[1] + gg[1] * a[1]; o[2] = xr[2] + gg[2] * a[2]; o[3] = xr[3] + gg[3] * a[3];
            *(f32x4*)(dst + col) = o;
          }
      }
  }
};
struct EpiAct {
  bf16_t* ACT;
  DI void operator()(const pg8::Acc& acc, const pg8::Unit& u, int wr, int wc, int fr, int fq) const {
#pragma unroll
    for (int ai = 0; ai < 2; ++ai)
#pragma unroll
      for (int m = 0; m < 4; ++m) {
        const int rl = u.rb * 256 + ai * 128 + wr * 64 + m * 16 + fr;
        if (rl < u.cnt) {
          bf16_t* rowp = ACT + (size_t)(u.rowbase + rl) * 512 + u.pn * 128 + 32 * wc + 8 * fq;
          f32x4 a, c;
#pragma unroll
          for (int i = 0; i < 4; ++i) { a[i] = silu_f(acc[ai][0][m][0][i]) * acc[ai][1][m][0][i]; c[i] = silu_f(acc[ai][0][m][1][i]) * acc[ai][1][m][1][i]; }
          st8bf(rowp, a, c);
        }
      }
  }
};
struct EpiDown {
  bf16_t* YS; const float* WTS; const int* LIST;
  DI void operator()(const pg8::Acc& acc, const pg8::Unit& u, int wr, int wc, int fr, int fq) const {
#pragma unroll
    for (int ai = 0; ai < 2; ++ai)
#pragma unroll
      for (int m = 0; m < 4; ++m) {
        const int rl = u.rb * 256 + ai * 128 + wr * 64 + m * 16 + fr;
        if (rl < u.cnt) {
          const int aid = LIST[(size_t)u.e * NTOK + rl];
          const float w = WTS[aid];
          bf16_t* rowp = YS + (size_t)aid * D + u.pn * 256 + 32 * wc + 8 * fq;
#pragma unroll
          for (int bj = 0; bj < 2; ++bj) { const f32x4 a = acc[ai][bj][m][0] * w, c = acc[ai][bj][m][1] * w; st8bf(rowp + 128 * bj, a, c); }
        }
      }
  }
};


enum { GK_A1 = 0, GK_GATES = 1, GK_PROJ = 2, GK_OUT = 3, GK_ACT = 4, GK_DOWN = 5 };
struct GemmJob {
  int gk, K; bool gather_rows, latent_only; int nM, nN, G, c, layer;
  const char* A; const char* B; const int* desc; const Params* pp;
  DI bool next(int i, pg8::Unit& u) const {
    if (gk >= GK_ACT) {
      MoeSched S{desc, (const int*)(pp->ws + WS_LIST), A, B, gk == GK_ACT};
      return S.next(i, u);
    }
    if (gk == GK_PROJ) { ProjSched S{A, B, nM, G, c, latent_only}; return S.next(i, u); }
    DenseSched S{A, B, nM, nN, K, G, c, latent_only, gk == GK_A1};
    return S.next(i, u);
  }
  DI void gather(const pg8::Unit& u, unsigned (&o)[2][2]) const {
    MoeSched S{desc, (const int*)(pp->ws + WS_LIST), A, B, true};
    S.gather(u, o);
  }
  DI void epilogue_proj(pg8::Acc& acc, const pg8::Unit& u, int wr, int wc, int fr, int fq) const {
    const Params& p = *pp;
    const bf16_t* Gsrc = (const bf16_t*)(p.ws + WS_G); EpiProj E{Gsrc, (bf16_t*)(p.ws + WS_MERGED)}; E(acc, u, wr, wc, fr, fq);
  }
  DI void epilogue(const pg8::Acc& acc, const pg8::Unit& u, int wr, int wc, int fr, int fq) const {
    const Params& p = *pp;
    switch (gk) {
      case GK_A1: { EpiA1 E{pp, layer}; E(acc, u, wr, wc, fr, fq); break; }
      case GK_GATES: { EpiGate E{(bf16_t*)(p.ws + WS_G)}; E(acc, u, wr, wc, fr, fq); break; }
      case GK_OUT: { EpiOut E{pp, layer}; E(acc, u, wr, wc, fr, fq); break; }
      case GK_ACT: { EpiAct E{(bf16_t*)(p.ws + WS_ACT)}; E(acc, u, wr, wc, fr, fq); break; }
      default: { EpiDown E{(bf16_t*)(p.ws + WS_YS), (const float*)(p.ws + WS_WTS), (const int*)(p.ws + WS_LIST)}; E(acc, u, wr, wc, fr, fq); break; }
    }
  }
};
DI GemmJob make_job(const Params& p, int gk, int layer, unsigned char* smem) {
  GemmJob j{}; j.gk = gk; j.layer = layer; j.pp = &p; j.G = (int)gridDim.x; j.c = (int)blockIdx.x; j.latent_only = false; j.gather_rows = false; j.desc = nullptr; j.nM = NTOK / 256; j.nN = 4; j.K = D;
  const bool lo = layer == 1;
  const char* wm = (const char*)(p.ws + WS_WMIX);
  switch (gk) {
    case GK_A1: j.A = (const char*)(p.ws + WS_H); j.B = wm + WM_WIN; j.nN = PCOLS / 256; break;
    case GK_GATES: j.A = (const char*)(p.ws + WS_H); j.B = wm + WM_WG; j.nN = 12; j.latent_only = lo; j.nM = lo ? 64 : 66; break;
    case GK_PROJ: j.A = (const char*)(p.ws + WS_Y); j.B = wm + WM_WP; j.K = 512; j.latent_only = lo; j.nM = lo ? 64 : 66; break;
    case GK_OUT: j.A = (const char*)(p.ws + WS_MERGED); j.B = wm + WM_WO; j.latent_only = lo; j.nM = lo ? 64 : 66; break;
    case GK_ACT: j.A = (const char*)(p.ws + WS_HX); j.B = (const char*)(p.ws + WS_WEXP); j.gather_rows = true; j.desc = moe_build_desc((const int*)(p.ws + WS_CNT) + layer * 16, (const int*)(p.ws + WS_LIST), true, smem); break;
    default: j.A = (const char*)(p.ws + WS_ACT); j.B = (const char*)(p.ws + WS_WEXP); j.K = 512; j.desc = moe_build_desc((const int*)(p.ws + WS_CNT) + layer * 16, (const int*)(p.ws + WS_LIST), false, smem); break;
  }
  return j;
}
__device__ __forceinline__ void phase_final(const Params& p) {
  const int tid_ = launder_tid(), lane = tid_ & 63, wave = tid_ >> 6;
  const bf16_t* YS = (const bf16_t*)(p.ws + WS_YS);
  for (int r = blockIdx.x * 8 + wave; r < NB * T; r += gridDim.x * 8) {
    const int b = r / T, t = r - b * T, g = b * NT + L + t;
    float* row = p.out + (size_t)r * D;
    const float* g5 = mod_ptr(p, 1, b, 5);
#pragma unroll
    for (int i = 0; i < 4; ++i) {
      const int col = (i * 64 + lane) * 4;
      f32x4 x = *(const f32x4*)(row + col);
      const u32x2 y0 = *(const u32x2*)(YS + (size_t)(2 * g) * D + col), y1 = *(const u32x2*)(YS + (size_t)(2 * g + 1) * D + col);
      const f32x4 gg = *(const f32x4*)(g5 + col);
      x[0] += gg[0] * (bf_lo(y0[0]) + bf_lo(y1[0])); x[1] += gg[1] * (bf_hi(y0[0]) + bf_hi(y1[0]));
      x[2] += gg[2] * (bf_lo(y0[1]) + bf_lo(y1[1])); x[3] += gg[3] * (bf_hi(y0[1]) + bf_hi(y1[1]));
      *(f32x4*)(row + col) = x;
    }
  }
}

__global__ void __launch_bounds__(NTHREADS, 2) mk_forward(Params p) {
  extern __shared__ __attribute__((aligned(16))) unsigned char smem[];
  volatile LAS unsigned* bst = (volatile LAS unsigned*)((LAS unsigned char*)smem + LDS_BYTES);
  if (threadIdx.x < 4) bst[threadIdx.x] = 0u;
  __syncthreads();
  const XcdBarrier gbar = xcd_barrier_post((unsigned*)(p.ws + WS_CTL), bst);
  phase_p0(p, smem);
  __syncthreads();
  conv_mixer(p, 0, smem);
  xcd_barrier(gbar);
#pragma unroll 1
  for (int step = 0; step < 22; ++step) {
    const int layer = step >= 11 ? 1 : 0, k = step - layer * 11;
    int gk = -1;
    if (k == 4 || (k == 5 && layer == 0)) phase_hg_b3(p, layer, smem, k == 5);
    switch (k) {
      case 0: phase_a0(p, layer); break;
      case 1: gk = GK_A1; break;
      case 2:
#pragma unroll 1
        for (int s_ = 0; s_ < 2; ++s_) { if (((s_ ^ (int)(blockIdx.x >> 3)) & 1) == 0) phase_hg_b1(p, layer, smem); else phase_attn(p, layer, smem); }
        break;
      case 3: phase_hg_b2(p, layer, smem); break;
      case 4: break;
      case 5: gk = GK_GATES; break;
      case 6: gk = GK_PROJ; break;
      case 7: gk = GK_OUT; break;
      case 8: phase_c3(p, layer, smem); if (layer == 0) { __syncthreads(); conv_mixer(p, 1, smem); } break;
      case 9: gk = GK_ACT; break;
      default: gk = GK_DOWN; break;
    }
    if (gk >= 0) {
      const GemmJob job = make_job(p, gk, layer, smem);
      if (gk == GK_PROJ) pg8::gemm_phase<GemmJob, true>((LAS unsigned char*)smem, job); else pg8::gemm_phase<GemmJob, false>((LAS unsigned char*)smem, job);
    }
    xcd_barrier(gbar);
  }
  phase_final(p);
}

extern "C" void kernel_launch(void* const* d_in, const int* in_sizes, int n_in, void* d_out, int out_size, void* d_ws, size_t ws_size,
                              hipStream_t stream) {
  static int grid_blocks = 0;
  if (!grid_blocks) {
    int dev = 0, cus = 0, per_cu = 0;
    (void)hipGetDevice(&dev);
    (void)hipDeviceGetAttribute(&cus, hipDeviceAttributeMultiprocessorCount, dev);
    (void)hipFuncSetAttribute((const void*)mk_forward, hipFuncAttributeMaxDynamicSharedMemorySize, LDS_BYTES + 16);
    (void)hipOccupancyMaxActiveBlocksPerMultiprocessor(&per_cu, (const void*)mk_forward, NTHREADS, LDS_BYTES + 16);
    if (per_cu < 1) { fprintf(stderr, "kernel_launch: occupancy query reports %d blocks per CU\n", per_cu); per_cu = 1; }
    grid_blocks = cus;
    if (ws_size < WS_TOTAL) fprintf(stderr, "kernel_launch: workspace too small: %zu < %zu\n", ws_size, (size_t)WS_TOTAL);
  }
  Params p{};
  const float* const* in = (const float* const*)d_in;
  p.x = in[0]; p.c = in[1]; p.ctx = in[2]; p.c_ctx = in[3]; p.w_ada = in[4]; p.b_ada = in[5]; p.norm1 = in[6]; p.norm2 = in[7]; p.w_in = in[8];
  p.na_qn = in[9]; p.na_kn = in[10]; p.na_rpb = in[11]; p.hg_lower = in[12]; p.hg_norm = in[13]; p.wa_qn = in[14]; p.wa_kn = in[15]; p.wa_sink = in[16];
  p.w_pa = in[17]; p.w_pb = in[18]; p.w_pc = in[19]; p.w_out = in[20]; p.w_router = in[21]; p.b_router = in[22]; p.w_gate = in[23]; p.w_up = in[24]; p.w_down = in[25];
  p.out = (float*)d_out; p.ws = (unsigned char*)d_ws;
  (void)hipMemsetAsync((char*)d_ws + WS_CTL, 0, CTL_BYTES, stream);
  void* args[] = {&p};
  hipError_t e = hipLaunchCooperativeKernel((const void*)mk_forward, dim3(grid_blocks), dim3(NTHREADS), args, LDS_BYTES + 16, stream);
  if (e != hipSuccess) fprintf(stderr, "cooperative launch failed: %s (grid %d)\n", hipGetErrorString(e), grid_blocks);
}
```
